# Optimizing an MI355X kernel written in HIP

```python
import math
import jax, jax.numpy as jnp
from jax import lax
import numpy as np

D_MODEL = 1024
BATCH = 2
SEQ = 16384
DEPTH = 2

N_META = 16
D_RNN = D_MODEL
RG_BLOCKS = 4
RG_BLOCK_W = D_RNN // RG_BLOCKS
CONV_W = 4
LRU_C = 8.0
N_HEADS = 8
HEAD_DIM = D_MODEL // N_HEADS
D_ATTN = N_HEADS * HEAD_DIM
IDX_HEADS = 8
IDX_DIM = 64
TOP_K_MAX = 256
Q_BLOCK = 128
N_BUCKETS = 32
MAX_DISTANCE = 128
D_FF = 4 * D_MODEL
NORM_EPS = 1e-6

SZ_RG_GATE = D_RNN
SZ_RG_X = D_RNN
SZ_Q = D_ATTN
SZ_K = D_ATTN
SZ_V = D_ATTN
SZ_QI = IDX_HEADS * IDX_DIM
SZ_KI = IDX_DIM
SZ_WI = IDX_HEADS
SZ_G_RNN = D_MODEL
SZ_G_ATTN = D_MODEL
IN_SIZES = (SZ_RG_GATE, SZ_RG_X, SZ_Q, SZ_K, SZ_V, SZ_QI, SZ_KI, SZ_WI, SZ_G_RNN, SZ_G_ATTN)
N_IN = sum(IN_SIZES)
SPLIT_POINTS = tuple(int(s) for s in np.cumsum(IN_SIZES)[:-1])

kernel_name = "hybrid_rglru_dsa_gated_block"


def rms_norm(x, g):
    xf = x.astype(jnp.float32)
    y = xf * lax.rsqrt(jnp.mean(xf * xf, axis=-1, keepdims=True) + NORM_EPS)
    return (y * g.astype(jnp.float32)).astype(x.dtype)


def causal_depthwise_conv(x, w, b):
    L = x.shape[1]
    xp = jnp.pad(x, ((0, 0), (CONV_W - 1, 0), (0, 0)))
    y = w[0] * xp[:, 0:L]
    for j in range(1, CONV_W):
        y = y + w[j] * xp[:, j:j + L]
    return y + b


def block_diag_linear(x, w, b):
    B, L, _ = x.shape
    xg = x.reshape(B, L, RG_BLOCKS, RG_BLOCK_W)
    return jnp.einsum('blgi,gij->blgj', xg, w).reshape(B, L, D_RNN) + b


def rg_lru(x, w_a, b_a, w_x, b_x, lam):
    r = jax.nn.sigmoid(block_diag_linear(x, w_a, b_a)).astype(jnp.float32)
    i = jax.nn.sigmoid(block_diag_linear(x, w_x, b_x)).astype(jnp.float32)
    log_a = -LRU_C * r * jax.nn.softplus(-lam.astype(jnp.float32))
    a = jnp.exp(log_a)
    u = jnp.sqrt(-jnp.expm1(2.0 * log_a)) * (i * x.astype(jnp.float32))

    def combine(c1, c2):
        a1, b1 = c1
        a2, b2 = c2
        return a1 * a2, a2 * b1 + b2

    _, h = lax.associative_scan(combine, (a, u), axis=1)
    return h.astype(x.dtype)


def t5_causal_bucket(dist):
    max_exact = N_BUCKETS // 2
    d = jnp.maximum(dist, 0)
    df = jnp.maximum(d, 1).astype(jnp.float32)
    large = max_exact + (jnp.log(df / max_exact) / math.log(MAX_DISTANCE / max_exact)
                         * (N_BUCKETS - max_exact)).astype(jnp.int32)
    large = jnp.minimum(large, N_BUCKETS - 1)
    return jnp.where(d < max_exact, d, large)


def sparse_indexed_attention(q, k, v, q_idx, k_idx, w_idx, rel_bias):
    B, L = q.shape[0], q.shape[1]
    top_k = min(TOP_K_MAX, L // 4)
    n_blocks = -(-L // Q_BLOCK)
    Lp = n_blocks * Q_BLOCK

    def pad(a):
        return jnp.pad(a, ((0, 0), (0, Lp - L)) + ((0, 0),) * (a.ndim - 2))

    qp, qip, wp = pad(q), pad(q_idx), pad(w_idx)
    key_pos = jnp.arange(L, dtype=jnp.int32)
    scale = HEAD_DIM ** -0.5
    gather = jax.vmap(lambda a, idx: a[idx])

    def one_block(blk):
        start = blk * Q_BLOCK
        qb = lax.dynamic_slice_in_dim(qp, start, Q_BLOCK, axis=1)
        qib = lax.dynamic_slice_in_dim(qip, start, Q_BLOCK, axis=1)
        wb = lax.dynamic_slice_in_dim(wp, start, Q_BLOCK, axis=1)
        t = start + jnp.arange(Q_BLOCK, dtype=jnp.int32)
        s_raw = jnp.einsum('bqhd,bkd->bqhk', qib, k_idx)
        score = jnp.einsum('bqhk,bqh->bqk', jax.nn.relu(s_raw), wb).astype(jnp.float32)
        causal = key_pos[None, None, :] <= t[None, :, None]
        score = jnp.where(causal, score, -jnp.inf)
        _, sel = lax.top_k(score, top_k)
        k_sel = gather(k, sel)
        v_sel = gather(v, sel)
        bias = rel_bias[t5_causal_bucket(t[None, :, None] - sel)]
        logits = (jnp.einsum('bqhd,bqkhd->bqhk', qb, k_sel).astype(jnp.float32) * scale
                  + jnp.moveaxis(bias, -1, 2).astype(jnp.float32))
        valid = (sel <= t[None, :, None])[:, :, None, :]
        logits = jnp.where(valid, logits, -jnp.inf)
        p = jax.nn.softmax(logits, axis=-1).astype(v.dtype)
        return jnp.einsum('bqhk,bqkhd->bqhd', p, v_sel)

    out = lax.map(one_block, jnp.arange(n_blocks, dtype=jnp.int32))
    out = jnp.moveaxis(out, 0, 1).reshape(B, Lp, N_HEADS, HEAD_DIM)[:, :L]
    return out


def hybrid_layer(h, norm1_g, w_in, conv_w, conv_b, w_rg_a, b_rg_a, w_rg_x, b_rg_x,
                 lru_lambda, w_out, norm2_g, w_mlp1, w_mlp2, rel_bias):
    B, L, _ = h.shape
    xn = rms_norm(h, norm1_g)
    proj = xn @ w_in
    (u_gate, u_rnn, q, k, v, qi, ki, wi, g_rnn, g_attn) = jnp.split(proj, SPLIT_POINTS, axis=-1)
    xc = causal_depthwise_conv(u_rnn, conv_w, conv_b)
    y_rnn = rg_lru(xc, w_rg_a, b_rg_a, w_rg_x, b_rg_x, lru_lambda) * jax.nn.gelu(u_gate)
    y_attn = sparse_indexed_attention(
        q.reshape(B, L, N_HEADS, HEAD_DIM), k.reshape(B, L, N_HEADS, HEAD_DIM),
        v.reshape(B, L, N_HEADS, HEAD_DIM), qi.reshape(B, L, IDX_HEADS, IDX_DIM),
        ki, wi, rel_bias).reshape(B, L, D_ATTN)
    y = jax.nn.sigmoid(g_rnn) * y_rnn + jax.nn.sigmoid(g_attn) * y_attn
    h = h + y @ w_out
    hn = rms_norm(h, norm2_g)
    h = h + jnp.square(jax.nn.relu(hn @ w_mlp1)) @ w_mlp2
    return h


def setup_inputs(seed: int = 0) -> dict:
    key = jax.random.key(seed)
    ks = jax.random.split(key, 20)
    f32 = jnp.float32
    x = jax.random.normal(ks[0], (BATCH, SEQ, D_MODEL), f32)
    norm1_g = 1.0 + 0.01 * jax.random.normal(ks[1], (DEPTH, D_MODEL), f32)
    w_in = jax.random.normal(ks[2], (DEPTH, D_MODEL, N_IN), f32) * D_MODEL ** -0.5
    conv_w = jax.random.normal(ks[3], (DEPTH, CONV_W, D_RNN), f32) * CONV_W ** -0.5
    conv_b = 0.01 * jax.random.normal(ks[4], (DEPTH, D_RNN), f32)
    w_rg_a = jax.random.normal(ks[5], (DEPTH, RG_BLOCKS, RG_BLOCK_W, RG_BLOCK_W), f32) * RG_BLOCK_W ** -0.5
    b_rg_a = 0.01 * jax.random.normal(ks[6], (DEPTH, D_RNN), f32)
    w_rg_x = jax.random.normal(ks[7], (DEPTH, RG_BLOCKS, RG_BLOCK_W, RG_BLOCK_W), f32) * RG_BLOCK_W ** -0.5
    b_rg_x = 0.01 * jax.random.normal(ks[8], (DEPTH, D_RNN), f32)
    a0 = jax.random.uniform(ks[9], (DEPTH, D_RNN), f32, minval=0.9, maxval=0.999)
    lru_lambda = jnp.log(a0) - jnp.log1p(-a0)
    w_out = jax.random.normal(ks[10], (DEPTH, D_MODEL, D_MODEL), f32) * D_MODEL ** -0.5
    norm2_g = 1.0 + 0.01 * jax.random.normal(ks[11], (DEPTH, D_MODEL), f32)
    w_mlp1 = jax.random.normal(ks[12], (DEPTH, D_MODEL, D_FF), f32) * D_MODEL ** -0.5
    w_mlp2 = jax.random.normal(ks[13], (DEPTH, D_FF, D_MODEL), f32) * D_FF ** -0.5
    rel_bias = 0.1 * jax.random.normal(ks[14], (N_BUCKETS, N_HEADS), f32)
    meta_tokens = jax.random.normal(ks[15], (N_META, D_MODEL), f32)
    final_g = 1.0 + 0.01 * jax.random.normal(ks[16], (D_MODEL,), f32)
    return {"x": x, "norm1_g": norm1_g, "w_in": w_in, "conv_w": conv_w, "conv_b": conv_b,
            "w_rg_a": w_rg_a, "b_rg_a": b_rg_a, "w_rg_x": w_rg_x, "b_rg_x": b_rg_x,
            "lru_lambda": lru_lambda, "w_out": w_out, "norm2_g": norm2_g,
            "w_mlp1": w_mlp1, "w_mlp2": w_mlp2, "rel_bias": rel_bias,
            "meta_tokens": meta_tokens, "final_g": final_g}


def reference(x, norm1_g, w_in, conv_w, conv_b, w_rg_a, b_rg_a, w_rg_x, b_rg_x,
              lru_lambda, w_out, norm2_g, w_mlp1, w_mlp2, rel_bias, meta_tokens, final_g):
    B = x.shape[0]
    meta = jnp.broadcast_to(meta_tokens[None].astype(x.dtype), (B, N_META, D_MODEL))
    h = jnp.concatenate([meta, x], axis=1)
    for l in range(DEPTH):
        h = hybrid_layer(h, norm1_g[l], w_in[l], conv_w[l], conv_b[l], w_rg_a[l], b_rg_a[l],
                         w_rg_x[l], b_rg_x[l], lru_lambda[l], w_out[l], norm2_g[l],
                         w_mlp1[l], w_mlp2[l], rel_bias)
    h = rms_norm(h, final_g)
    return h[:, N_META:]
```

```cpp
#include <hip/hip_runtime.h>
#include <cstdio>
#include <cstdint>

#define LAS __attribute__((address_space(3)))
typedef unsigned short bf16_t;
typedef short bf16x8 __attribute__((ext_vector_type(8)));
typedef short s16x4 __attribute__((ext_vector_type(4)));
typedef float f32x4 __attribute__((ext_vector_type(4)));
typedef float f32x2 __attribute__((ext_vector_type(2)));
typedef float f32x16 __attribute__((ext_vector_type(16)));
typedef unsigned u32x4 __attribute__((ext_vector_type(4)));
typedef unsigned u32x2 __attribute__((ext_vector_type(2)));
typedef _Float16 h16x4 __attribute__((ext_vector_type(4)));
typedef _Float16 h16x2 __attribute__((ext_vector_type(2)));
typedef _Float16 h16x4 __attribute__((ext_vector_type(4)));

constexpr int NB = 2, SEQ = 16384, NMETA = 16, PADF = 240, RA = 16640, R = NB * RA;
constexpr int D = 1024, NH = 8, HD = 128, IH = 8, IDIM = 64, FF = 4096, NIN = 7752, DEPTH = 2;
constexpr float EPS = 1e-6f;
constexpr int NA = 3072, NBP = 4864;
constexpr int WIN_ROWS = NA + NBP;
constexpr int NWAVES = 8, NTHREADS = 512;

constexpr size_t MiB = 1u << 20;
constexpr size_t SLOT = (size_t)R * D * 2;
constexpr size_t WS_CTL = 0, CTL_ZERO_BYTES = 1 * MiB;
constexpr size_t WS_WIN = 1 * MiB;
constexpr size_t WS_WOUT = 33 * MiB;
constexpr size_t WS_W1 = 37 * MiB;
constexpr size_t WS_W2 = 53 * MiB;
constexpr size_t WS_WRG = 69 * MiB;
constexpr size_t WS_HMETA = 71 * MiB;
constexpr size_t WS_WI = 73 * MiB;
constexpr size_t WS_KI = 75 * MiB;
constexpr size_t WS_QI = 80 * MiB;
constexpr size_t WS_AGG = 113 * MiB;
constexpr size_t WS_CARRY = 118 * MiB;
constexpr size_t WS_LUT = 121 * MiB;
constexpr size_t WS_A0 = 122 * MiB, WS_A1 = 187 * MiB, WS_B0 = 252 * MiB, WS_B1 = 317 * MiB, WS_B2 = 382 * MiB, WS_B3 = 447 * MiB, WS_END = 512 * MiB;
static_assert(SLOT == 65 * MiB && WS_B3 + SLOT == WS_END, "ws map");
constexpr int NCHUNK = 256, CHROWS = 65;
constexpr int MASK_CHUNKS_PER_BATCH = 2 * 65 * 66;

constexpr int LDS_BYTES = 147456;
constexpr int MISC_OFF = 131072 + 4096;

#define GAS __attribute__((address_space(1)))
template <class T> __device__ __forceinline__ T* as_global(T* p) { return (T*)(GAS T*)p; }
__device__ __forceinline__ int opaque_tid(int wid0) { int l; asm volatile("v_mbcnt_lo_u32_b32 %0, -1, 0\n\tv_mbcnt_hi_u32_b32 %0, -1, %0" : "=v"(l)); return wid0 * 64 + l; }
__device__ __forceinline__ unsigned cvt_pk_bf16(float lo, float hi) { unsigned r; asm volatile("v_cvt_pk_bf16_f32 %0, %1, %2" : "=v"(r) : "v"(lo), "v"(hi)); return r; }
__device__ __forceinline__ float bf_lo(unsigned w) { return __uint_as_float(w << 16); }
__device__ __forceinline__ float bf_hi(unsigned w) { return __uint_as_float(w & 0xffff0000u); }
__device__ __forceinline__ float wave_sum(float v) {
#pragma unroll
    for (int o = 1; o < 64; o <<= 1) v += __shfl_xor(v, o);
    return v;
}
__device__ __forceinline__ float sigmoidf_(float x) { return 1.0f / (1.0f + __expf(-x)); }
__device__ __forceinline__ float sigm_fast(float x) { return __builtin_amdgcn_rcpf(1.0f + __expf(-x)); }
__device__ __forceinline__ float gelu_tanh(float x) { const float z = 0.7978845608028654f * (x + 0.044715f * x * x * x); const float t = 1.0f - 2.0f / (__expf(2.0f * z) + 1.0f); return 0.5f * x * (1.0f + t); }
__device__ __forceinline__ float* hrow(float* out, float* hmeta, int r) {
    const int b = r >= RA ? 1 : 0, a = r - b * RA;
    return a >= 256 ? out + ((size_t)(b * SEQ + a - 256) << 10) : hmeta + ((size_t)(b * 256 + a) << 10);
}

#define XB_TMO      128
#define XB_XCNT(j)  (256  + 64 * (j))
#define XB_XSUB(j)  (1280 + 64 * (j))
#define XB_XGEN(j)  (2304 + 64 * (j))
#define XB_TOP      3328
#define XB_TOPGEN   3392
#define XCD_BAR_WORDS 3456
#define XB_SPIN_CAP (1u << 22)
__device__ __forceinline__ unsigned xb_ld(unsigned* p)              { return __hip_atomic_load(p, __ATOMIC_RELAXED, __HIP_MEMORY_SCOPE_AGENT); }
__device__ __forceinline__ unsigned xb_add(unsigned* p, unsigned v) { return __hip_atomic_fetch_add(p, v, __ATOMIC_RELAXED, __HIP_MEMORY_SCOPE_AGENT); }
__device__ __forceinline__ unsigned xb_xcc_id() { return (unsigned)__builtin_amdgcn_s_getreg((3 << 11) | 20) & 0xFu; }
#define XB_SPIN(cond, bar) do { unsigned _sp = 0; while (cond) { __builtin_amdgcn_s_sleep(1); \
    if ((++_sp & 255u) == 0u) { if (xb_ld(&(bar)[XB_TMO])) break; if (_sp > XB_SPIN_CAP) { atomicAdd(&(bar)[XB_TMO], 1u); break; } } } } while (0)
struct XcdBarrier { unsigned* bar; unsigned x; volatile LAS unsigned* st; };
__device__ __forceinline__ XcdBarrier xcd_barrier_post(unsigned* bar, volatile LAS unsigned* st) {
    XcdBarrier b; b.bar = bar; b.x = xb_xcc_id(); b.st = st;
    if (threadIdx.x == 0) (void)xb_add(&bar[XB_XCNT(b.x)], 1u);
    return b;
}
__device__ __forceinline__ void xcd_barrier_complete(unsigned* bar, unsigned x, unsigned& nloc, unsigned& nx) {
    const unsigned G = gridDim.x * gridDim.y * gridDim.z;
    unsigned sum, cnt, mine, sp = 0u;
    for (;;) {
        sum = 0u; cnt = 0u; mine = 0u;
#pragma unroll
        for (unsigned j = 0; j < 16; ++j) { const unsigned c = xb_ld(&bar[XB_XCNT(j)]); sum += c; cnt += (c > 0u) ? 1u : 0u; mine = (j == x) ? c : mine; }
        if (sum == G) break;
        __builtin_amdgcn_s_sleep(1);
        if ((++sp & 255u) == 0u) { if (xb_ld(&bar[XB_TMO])) break; if (sp > XB_SPIN_CAP) { atomicAdd(&bar[XB_TMO], 1u); break; } }
    }
    nloc = mine > 0u ? mine : 1u; nx = cnt > 0u ? cnt : 1u;
}
__device__ __forceinline__ void xcd_barrier(const XcdBarrier& b, const int tid) {
    asm volatile("s_waitcnt vmcnt(0)" ::: "memory");
    __syncthreads();
    if (tid == 0) {
        unsigned* bar = b.bar;
        __builtin_amdgcn_s_waitcnt(0);
        unsigned nloc = b.st[0], nx = b.st[1];
        if (nloc == 0u) { xcd_barrier_complete(bar, b.x, nloc, nx); b.st[0] = nloc; b.st[1] = nx; }
        const unsigned old = xb_add(&bar[XB_XSUB(b.x)], 1u);
        const unsigned gen = old / nloc;
        if (old + 1u == (gen + 1u) * nloc) {
            __builtin_amdgcn_fence(__ATOMIC_RELEASE, "agent");
            asm volatile("s_waitcnt vmcnt(0)" ::: "memory");
            const unsigned og = xb_add(&bar[XB_TOP], 1u);
            const unsigned tg = og / nx;
            if (og + 1u == (tg + 1u) * nx) xb_add(&bar[XB_TOPGEN], 1u);
            else XB_SPIN(xb_ld(&bar[XB_TOPGEN]) == tg, bar);
            __builtin_amdgcn_fence(__ATOMIC_ACQUIRE, "agent");
            xb_add(&bar[XB_XGEN(b.x)], 1u);
            asm volatile("s_waitcnt vmcnt(0)" ::: "memory");
        } else {
            XB_SPIN(xb_ld(&bar[XB_XGEN(b.x)]) == gen, bar);
            __builtin_amdgcn_fence(__ATOMIC_ACQUIRE, "agent");
            asm volatile("s_waitcnt vmcnt(0)" ::: "memory");
        }
    }
    __syncthreads();
}

namespace pg8 {
constexpr int BM = 256, BK = 64, HALF = 128, HTB = HALF * BK * 2, STAGE_BYTES = 8 * HTB, NXCD = 8, WGM = 8;
__host__ __device__ __forceinline__ int lds_byte(int r, int c) { const int st = (r >> 4) * 2 + (c >> 5), rr = r & 15, cc = c & 31, ob = rr * 64 + cc * 2; return st * 1024 + (ob ^ (((ob >> 9) & 1) << 5)); }
__host__ __device__ __forceinline__ void stage_rc(int b, int& R_, int& C) { const int st = b / 1024, sb = b % 1024, swz = sb ^ (((sb >> 9) & 1) << 5); R_ = (st >> 1) * 16 + swz / 64; C = (st & 1) * 32 + (swz % 64) / 2; }
__host__ __device__ __forceinline__ int perm32(int rho) { const int n = rho >> 4, i = rho & 15; return 8 * (i >> 2) + 4 * n + (i & 3); }
struct Unit { int pm, pn; };
struct Gemm { const bf16_t* A; const bf16_t* Bt; int lda, ldb, K; };
struct StaticOrder {
    int nM, nN, nwg, G, c;
    __device__ void init(int M, int N, int G_, int c_) { nM = M / BM; nN = N / BM; nwg = nM * nN; G = G_; c = c_; }
    __device__ bool next(int i, Unit& u) const {
        const long L = (long)i * G + c; if (L >= nwg) return false;
        int wgid = (int)L; { const int q = nwg / NXCD, r = nwg % NXCD, xcd = wgid % NXCD, off = wgid / NXCD; wgid = (xcd < r ? xcd * (q + 1) : r * (q + 1) + (xcd - r) * q) + off; }
        const int nig = WGM * nN, gid = wgid / nig, fm = gid * WGM, gsz = (nM - fm) < WGM ? (nM - fm) : WGM;
        const int pml = fm + ((wgid % nig) % gsz); u.pm = pml + 1 + (pml >> 6);
        u.pn = (wgid % nig) / gsz; return true;
    }
    __device__ __forceinline__ size_t a_off(const Unit&) const { return 0; }
};
struct GroupOrder : StaticOrder {
    __device__ __forceinline__ size_t a_off(const Unit& u) const { return (size_t)(u.pn >> 1) * 256 * 2; }
};

template <class Epi, class Sched>
__device__ __forceinline__ void gemm_phase(LAS unsigned char* lds, const Gemm g, const Sched& S, const Epi& E, const int wid0) {
    const int tid = opaque_tid(wid0), wid = __builtin_amdgcn_readfirstlane(tid >> 6), lane = tid & 63, wr = wid >> 2, wc = wid & 3, fr = lane & 15, fq = lane >> 4;
    int K = g.K; asm volatile("" : "+s"(K));
    const int nt = K / BK;
    unsigned voffA[2], voffB[2];
#pragma unroll
    for (int i = 0; i < 2; ++i) { int R_, C; stage_rc(tid * 16 + i * 8192, R_, C); const int Rb = Epi::PERM ? ((R_ & ~31) + perm32(R_ & 31)) : R_;
        voffA[i] = (unsigned)(R_ * g.lda + C) * 2u; voffB[i] = (unsigned)(Rb * g.ldb + C) * 2u; }
    const size_t kstep = (size_t)(BK * 2);
    const size_t hstepA = (size_t)HALF * g.lda * 2, hstepB = (size_t)HALF * g.ldb * 2;
    const size_t tstepA = 2 * hstepA, tstepB = 2 * hstepB;
    const unsigned ldsw = (unsigned)wid * 1024u;
    const int aoff = lds_byte(wr * 64 + fr, fq * 8), boff = lds_byte(wc * 32 + fr, fq * 8);
#define PG8_SA(b, h) (((b) * 2 + (h)) * HTB)
#define PG8_SB(b, h) ((4 + (b) * 2 + (h)) * HTB)
#define PG8_STAGE(bufoff, gbase, voff) do { _Pragma("unroll") for (int _i = 0; _i < 2; ++_i) \
        __builtin_amdgcn_global_load_lds((const unsigned*)((const char*)(gbase) + (voff)[_i]), (LAS unsigned*)(lds + (bufoff) + ldsw + _i * 8192), 16, 0, 0); } while (0)
#define PG8_LDA(dst, b, h) do { _Pragma("unroll") for (int m = 0; m < 4; ++m) _Pragma("unroll") for (int k = 0; k < 2; ++k) dst[m][k] = *(const LAS bf16x8*)(lds + PG8_SA(b, h) + aoff + m * 2048 + k * 1024); } while (0)
#define PG8_LDB(dst, b, h) do { _Pragma("unroll") for (int n = 0; n < 2; ++n) _Pragma("unroll") for (int k = 0; k < 2; ++k) dst[n][k] = *(const LAS bf16x8*)(lds + PG8_SB(b, h) + boff + n * 2048 + k * 1024); } while (0)
#define PG8_MMA(ai, bj, At, Bt) do { __builtin_amdgcn_s_setprio(1); _Pragma("unroll") for (int m = 0; m < 4; ++m) _Pragma("unroll") for (int n = 0; n < 2; ++n) _Pragma("unroll") for (int k = 0; k < 2; ++k) \
        acc[ai][bj][m][n] = __builtin_amdgcn_mfma_f32_16x16x32_bf16(Bt[n][k], At[m][k], acc[ai][bj][m][n], 0, 0, 0); __builtin_amdgcn_s_setprio(0); } while (0)
#define PG8_WAIT_V(n) asm volatile("s_waitcnt vmcnt(" #n ")" ::: "memory")
#define PG8_WAIT_L(n) asm volatile("s_waitcnt lgkmcnt(" #n ")" ::: "memory")
#define PG8_BAR __builtin_amdgcn_s_barrier()
#define PG8_SCHED __builtin_amdgcn_sched_barrier(0)
    Unit cur, nxt; int ui = 0;
    if (!S.next(0, cur)) return;
    f32x4 acc[2][2][4][2];
#pragma unroll
    for (int a = 0; a < 2; ++a)
#pragma unroll
        for (int b = 0; b < 2; ++b)
#pragma unroll
            for (int m = 0; m < 4; ++m)
#pragma unroll
                for (int n = 0; n < 2; ++n) acc[a][b][m][n] = (f32x4){0.f, 0.f, 0.f, 0.f};
    bf16x8 At[4][2], B0[2][2], B1[2][2];
    const char* cA = (const char*)g.A + (size_t)cur.pm * tstepA + S.a_off(cur); const char* cB = (const char*)g.Bt + (size_t)cur.pn * tstepB;
    PG8_STAGE(PG8_SB(0, 0), cB, voffB); PG8_STAGE(PG8_SB(0, 1), cB + hstepB, voffB); PG8_STAGE(PG8_SA(0, 0), cA, voffA); PG8_STAGE(PG8_SA(0, 1), cA + hstepA, voffA);
    if (wr == 1) PG8_BAR;
    PG8_WAIT_V(2); PG8_BAR;
    PG8_STAGE(PG8_SB(1, 0), cB + kstep, voffB); PG8_STAGE(PG8_SA(1, 0), cA + kstep, voffA); PG8_STAGE(PG8_SB(1, 1), cB + hstepB + kstep, voffB);
    PG8_WAIT_V(6); PG8_BAR;
    for (;;) {
        const bool has_next = S.next(ui + 1, nxt);
        const char* nA = has_next ? (const char*)g.A + (size_t)nxt.pm * tstepA + S.a_off(nxt) : cA; const char* nB = has_next ? (const char*)g.Bt + (size_t)nxt.pn * tstepB : cB;
        for (int t = 0; t < nt; t += 2) {
            const bool last = (t == nt - 2);
            const char* a1 = cA + (size_t)(t + 1) * kstep;
            const char* a2 = last ? nA : cA + (size_t)(t + 2) * kstep; const char* b2 = last ? nB : cB + (size_t)(t + 2) * kstep;
            const char* a3 = a2 + kstep; const char* b3 = b2 + kstep;
            PG8_LDB(B0, 0, 0); PG8_LDB(B1, 0, 1); PG8_SCHED; PG8_LDA(At, 0, 0); PG8_STAGE(PG8_SA(1, 1), a1 + hstepA, voffA);
            PG8_WAIT_V(8); PG8_WAIT_L(0); PG8_BAR; PG8_MMA(0, 0, At, B0); PG8_MMA(0, 1, At, B1); PG8_BAR; PG8_SCHED;
            PG8_LDA(At, 0, 1); PG8_STAGE(PG8_SB(0, 0), b2, voffB); PG8_STAGE(PG8_SB(0, 1), b2 + hstepB, voffB); PG8_STAGE(PG8_SA(0, 0), a2, voffA);
            PG8_WAIT_V(8); PG8_WAIT_L(0); PG8_BAR; PG8_MMA(1, 0, At, B0); PG8_MMA(1, 1, At, B1); PG8_BAR; PG8_SCHED;
            PG8_LDB(B0, 1, 0); PG8_LDB(B1, 1, 1); PG8_SCHED; PG8_LDA(At, 1, 0); PG8_STAGE(PG8_SA(0, 1), a2 + hstepA, voffA);
            PG8_WAIT_V(8); PG8_WAIT_L(0); PG8_BAR; PG8_MMA(0, 0, At, B0); PG8_MMA(0, 1, At, B1); PG8_BAR; PG8_SCHED;
            PG8_LDA(At, 1, 1); PG8_STAGE(PG8_SB(1, 0), b3, voffB); PG8_STAGE(PG8_SB(1, 1), b3 + hstepB, voffB); PG8_STAGE(PG8_SA(1, 0), a3, voffA);
            PG8_WAIT_V(8); PG8_WAIT_L(0); PG8_BAR; PG8_MMA(1, 0, At, B0); PG8_MMA(1, 1, At, B1); PG8_BAR; PG8_SCHED;
        }
        if (wr == 0) PG8_BAR;
        E(acc, cur, wr, wc, fr, fq);
        if (!has_next) break;
#pragma unroll
        for (int a = 0; a < 2; ++a)
#pragma unroll
            for (int b = 0; b < 2; ++b)
#pragma unroll
                for (int m = 0; m < 4; ++m)
#pragma unroll
                    for (int n = 0; n < 2; ++n) acc[a][b][m][n] = (f32x4){0.f, 0.f, 0.f, 0.f};
        cur = nxt; cA = nA; cB = nB; ++ui;
        if (wr == 1) PG8_BAR;
    }
    PG8_WAIT_V(0);
    PG8_BAR;
#undef PG8_SA
#undef PG8_SB
#undef PG8_STAGE
#undef PG8_LDA
#undef PG8_LDB
#undef PG8_MMA
#undef PG8_WAIT_V
#undef PG8_WAIT_L
#undef PG8_BAR
#undef PG8_SCHED
}

struct EpiProj {
    static constexpr bool PERM = true;
    bf16_t* d0; bf16_t* d1; bf16_t* d2; bf16_t* d3; bf16_t* qi; bf16_t* ki; float* wi;
    __device__ __forceinline__ void operator()(const f32x4 (&acc)[2][2][4][2], const Unit& u, int wr, int wc, int fr, int fq) const {
        const int row0 = u.pm * BM + wr * 64 + fr;
#pragma unroll
        for (int bj = 0; bj < 2; ++bj) {
            const int colb = u.pn * BM + bj * HALF + wc * 32 + 8 * fq;
            bf16_t* base; int ld, c; bool isf = false, skip = false;
            if (colb < 4096) { const int t = colb >> 10; base = t == 0 ? d0 : t == 1 ? d1 : t == 2 ? d2 : d3; ld = 1024; c = colb & 1023; }
            else if (colb < 4608) { base = qi; ld = 512; c = colb - 4096; }
            else if (colb < 4672) { base = ki; ld = 64; c = colb - 4608; }
            else if (colb == 4672) { base = nullptr; ld = 8; c = 0; isf = true; }
            else { base = nullptr; ld = 0; c = 0; skip = true; }
            if (skip) continue;
#pragma unroll
            for (int ai = 0; ai < 2; ++ai)
#pragma unroll
                for (int m = 0; m < 4; ++m) { const int row = row0 + ai * HALF + m * 16; const f32x4 v0 = acc[ai][bj][m][0], v1 = acc[ai][bj][m][1];
                    if (isf) { float* p = wi + (size_t)row * 8; *(f32x4*)p = v0; *(f32x4*)(p + 4) = v1; }
                    else { u32x4 w; w.x = cvt_pk_bf16(v0[0], v0[1]); w.y = cvt_pk_bf16(v0[2], v0[3]); w.z = cvt_pk_bf16(v1[0], v1[1]); w.w = cvt_pk_bf16(v1[2], v1[3]);
                        *(u32x4*)(base + (size_t)row * ld + c) = w; } }
        }
    }
};
struct EpiRes {
    static constexpr bool PERM = false;
    float* out; float* hmeta; int dry; long sdelta;
    __device__ __forceinline__ void operator()(const f32x4 (&acc)[2][2][4][2], const Unit& u, int wr, int wc, int fr, int fq) const {
        if (dry) return;
        const int row0 = u.pm * BM + wr * 64 + fr, col0 = u.pn * BM + wc * 32 + 4 * fq;
#pragma unroll
        for (int ai = 0; ai < 2; ++ai)
#pragma unroll
            for (int m = 0; m < 4; ++m) { float* rowp = hrow(out, hmeta, row0 + ai * HALF + m * 16) + col0;
#pragma unroll
                for (int bj = 0; bj < 2; ++bj)
#pragma unroll
                    for (int n = 0; n < 2; ++n) { f32x4* p = (f32x4*)(rowp + bj * HALF + n * 16); *p = *(const f32x4*)((const float*)p + sdelta) + acc[ai][bj][m][n]; } }
    }
};
struct EpiRelu2 {
    static constexpr bool PERM = true;
    bf16_t* O; int ldc;
    __device__ __forceinline__ void operator()(const f32x4 (&acc)[2][2][4][2], const Unit& u, int wr, int wc, int fr, int fq) const {
        const int row0 = u.pm * BM + wr * 64 + fr, col0 = u.pn * BM + wc * 32 + 8 * fq;
#pragma unroll
        for (int ai = 0; ai < 2; ++ai)
#pragma unroll
            for (int m = 0; m < 4; ++m) { bf16_t* rowp = O + (size_t)(row0 + ai * HALF + m * 16) * ldc + col0;
#pragma unroll
                for (int bj = 0; bj < 2; ++bj) { f32x4 v0 = acc[ai][bj][m][0], v1 = acc[ai][bj][m][1];
#pragma unroll
                    for (int j = 0; j < 4; ++j) { const float a = fmaxf(v0[j], 0.f), b = fmaxf(v1[j], 0.f); v0[j] = a * a; v1[j] = b * b; }
                    u32x4 w; w.x = cvt_pk_bf16(v0[0], v0[1]); w.y = cvt_pk_bf16(v0[2], v0[3]); w.z = cvt_pk_bf16(v1[0], v1[1]); w.w = cvt_pk_bf16(v1[2], v1[3]);
                    *(u32x4*)(rowp + bj * HALF) = w; } }
    }
};
struct EpiRGPre {
    static constexpr bool PERM = true;
    bf16_t* PA; bf16_t* PX;
    __device__ __forceinline__ void operator()(const f32x4 (&acc)[2][2][4][2], const Unit& u, int wr, int wc, int fr, int fq) const {
        const int row0 = u.pm * BM + wr * 64 + fr, col0 = (u.pn >> 1) * 256 + wc * 32 + 8 * fq;
        bf16_t* base = (bf16_t*)((char*)PA + ((u.pn & 1) ? (size_t)((const char*)PX - (const char*)PA) : (size_t)0));
#pragma unroll
        for (int ai = 0; ai < 2; ++ai)
#pragma unroll
            for (int m = 0; m < 4; ++m) { bf16_t* rowp = base + (size_t)(row0 + ai * HALF + m * 16) * D + col0;
#pragma unroll
                for (int bj = 0; bj < 2; ++bj) { const f32x4 v0 = acc[ai][bj][m][0], v1 = acc[ai][bj][m][1];
                    u32x4 w; w.x = cvt_pk_bf16(v0[0], v0[1]); w.y = cvt_pk_bf16(v0[2], v0[3]); w.z = cvt_pk_bf16(v1[0], v1[1]); w.w = cvt_pk_bf16(v1[2], v1[3]);
                    *(u32x4*)(rowp + bj * HALF) = w; } }
    }
};
}

template <class Epi>
__device__ __forceinline__ void meta_gemm(LAS unsigned char* lds, const bf16_t* A, int lda, const bf16_t* Bt, int ldb, int N, int K, int wgsplit, int ngroups, const Epi& epi, const int wid0) {
    const int tid = opaque_tid(wid0), lane = tid & 63, wid = __builtin_amdgcn_readfirstlane(tid >> 6), m16 = lane & 15, kq = lane >> 4;
    const int ncg = N / 16, Kw = K / wgsplit, Kv = Kw / NWAVES, ntask = ncg * wgsplit, cpg = ncg / ngroups;
    LAS float* part = (LAS float*)lds;
    for (int task = (int)gridDim.x - 1 - (int)blockIdx.x; task < ntask; task += (int)gridDim.x) {
        const int cg = task % ncg, kc = task / ncg, n0 = cg * 16, grp = cg / cpg, kbase = kc * Kw + wid * Kv;
        const bf16_t* a0 = A + (size_t)(PADF + m16) * lda + (size_t)grp * 256 * (ngroups > 1) + kbase + 8 * kq;
        const bf16_t* a1 = a0 + (size_t)RA * lda;
        const bf16_t* bp = Bt + (size_t)(n0 + m16) * ldb + kbase + 8 * kq;
        f32x4 acc0 = {0.f, 0.f, 0.f, 0.f}, acc1 = {0.f, 0.f, 0.f, 0.f};
#pragma unroll 4
        for (int k0 = 0; k0 < Kv; k0 += 32) {
            const bf16x8 fa0 = *(const bf16x8*)(a0 + k0), fa1 = *(const bf16x8*)(a1 + k0), fb = *(const bf16x8*)(bp + k0);
            acc0 = __builtin_amdgcn_mfma_f32_16x16x32_bf16(fa0, fb, acc0, 0, 0, 0);
            acc1 = __builtin_amdgcn_mfma_f32_16x16x32_bf16(fa1, fb, acc1, 0, 0, 0);
        }
        *(LAS f32x4*)(part + (wid * 64 + lane) * 8) = acc0; *(LAS f32x4*)(part + (wid * 64 + lane) * 8 + 4) = acc1;
        __syncthreads();
        {
            const int m = tid >> 4, n = tid & 15, src = ((((m & 15) >> 2) * 16 + n) * 8) + (m >> 4) * 4 + (m & 3);
            float v = 0.f;
#pragma unroll
            for (int w = 0; w < NWAVES; ++w) v += part[w * 512 + src];
            epi((m >> 4) * RA + PADF + (m & 15), n0 + n, v);
        }
        __syncthreads();
    }
}
struct MEpiProj { bf16_t* d0; bf16_t* d1; bf16_t* d2; bf16_t* d3; bf16_t* qi; bf16_t* ki; float* wi;
    __device__ __forceinline__ void operator()(int row, int col, float v) const {
        if (col < 4096) { const int t = col >> 10; bf16_t* base = t == 0 ? d0 : t == 1 ? d1 : t == 2 ? d2 : d3; base[(size_t)row * 1024 + (col & 1023)] = (bf16_t)(cvt_pk_bf16(v, 0.f) & 0xffffu); }
        else if (col < 4608) qi[(size_t)row * 512 + (col - 4096)] = (bf16_t)(cvt_pk_bf16(v, 0.f) & 0xffffu);
        else if (col < 4672) ki[(size_t)row * 64 + (col - 4608)] = (bf16_t)(cvt_pk_bf16(v, 0.f) & 0xffffu);
        else if (col < 4680) wi[(size_t)row * 8 + (col - 4672)] = v;
    } };
struct MEpiRG { bf16_t* PA; bf16_t* PX;
    __device__ __forceinline__ void operator()(int row, int col, float v) const { const int g = col >> 9, c = col & 511; bf16_t* base = (bf16_t*)((char*)PA + ((c & 256) ? (size_t)((const char*)PX - (const char*)PA) : (size_t)0)); base[(size_t)row * 1024 + g * 256 + (c & 255)] = (bf16_t)(cvt_pk_bf16(v, 0.f) & 0xffffu); } };
struct MEpiRes { float* out; float* hmeta;
    __device__ __forceinline__ void operator()(int row, int col, float v) const { atomicAdd(hrow(out, hmeta, row) + col, v); } };
struct MEpiRelu2 { bf16_t* O;
    __device__ __forceinline__ void operator()(int row, int col, float v) const { const float a = fmaxf(v, 0.f); O[(size_t)row * FF + col] = (bf16_t)(cvt_pk_bf16(a * a, 0.f) & 0xffffu); } };

struct Args {
    const float* x; const float* norm1_g; const float* w_in; const float* conv_w; const float* conv_b;
    const float* w_rg_a; const float* b_rg_a; const float* w_rg_x; const float* b_rg_x; const float* lru_lambda;
    const float* w_out; const float* norm2_g; const float* w_mlp1; const float* w_mlp2; const float* rel_bias;
    const float* meta; const float* final_g; float* out; unsigned char* ws; int ph_lo, ph_hi;
};

__device__ __forceinline__ void transpose_item(const float* W, int ldw, int K, int kb, int src_col0, int nvalid, bf16_t* WT, int dst_row0, int dst_stride, LAS float* scr, int lane, const float wscale = 1.0f) {
    const int k0 = 64 * kb, c4 = (lane & 7) * 4;
    f32x4 ld[8];
#pragma unroll
    for (int i = 0; i < 8; ++i) { const int kk = (lane >> 3) + 8 * i; ld[i] = (c4 < nvalid) ? *(const f32x4*)(W + (size_t)(k0 + kk) * ldw + src_col0 + c4) : (f32x4){0.f, 0.f, 0.f, 0.f}; }
#pragma unroll
    for (int i = 0; i < 8; ++i) { const int kk = (lane >> 3) + 8 * i;
#pragma unroll
        for (int j = 0; j < 4; ++j) scr[kk * 33 + c4 + j] = ld[i][j] * wscale; }
    asm volatile("s_waitcnt lgkmcnt(0)" ::: "memory");
    const int c8 = lane & 7;
#pragma unroll
    for (int j = 0; j < 4; ++j) { const int n = (lane >> 3) + 8 * j; const LAS float* s = scr + (8 * c8) * 33 + n;
        u32x4 o; o.x = cvt_pk_bf16(s[0 * 33], s[1 * 33]); o.y = cvt_pk_bf16(s[2 * 33], s[3 * 33]); o.z = cvt_pk_bf16(s[4 * 33], s[5 * 33]); o.w = cvt_pk_bf16(s[6 * 33], s[7 * 33]);
        *(u32x4*)(WT + (size_t)(dst_row0 + n * dst_stride) * K + k0 + 8 * c8) = o; }
    asm volatile("s_waitcnt lgkmcnt(0)" ::: "memory");
}
__device__ __forceinline__ int win_src(int drow, int& nvalid) {
    nvalid = 32;
    if (drow < 2048) return drow;
    if (drow < 3072) return 5704 + (drow - 2048);
    const int j = drow - 3072;
    if (j < 1024) return 2048 + j;
    if (j < 2048) return 3072 + (j - 1024);
    if (j < 3072) return 4096 + (j - 2048);
    if (j < 4096) return 6728 + (j - 3072);
    if (j < 4608) return 5120 + (j - 4096);
    if (j < 4672) return 5632 + (j - 4608);
    if (j == 4672) { nvalid = 8; return 5696; }
    nvalid = 0; return 0;
}
__device__ __forceinline__ int t5_bucket(int d) {
    if (d < 16) return d;
    int v = 16 + (int)(logf((float)d / 16.0f) / logf(8.0f) * 16.0f);
    return v > 31 ? 31 : v;
}
__device__ __forceinline__ void phase_prologue(const Args& A, LAS unsigned char* lds, const int wid0) {
    const int tid = opaque_tid(wid0), lane = tid & 63, wave = __builtin_amdgcn_readfirstlane(tid >> 6), gw = blockIdx.x * NWAVES + wave, NGW = gridDim.x * NWAVES;
    LAS float* scr = (LAS float*)(lds + wave * 16384);
    constexpr int I_IN = (WIN_ROWS / 32) * 16, I_OUT = 32 * 16, I_1 = 128 * 16, I_2 = 32 * 64, I_RG = 2 * 4 * 8 * 4, I_L = I_IN + I_OUT + I_1 + I_2 + I_RG;
    for (int it = gw; it < DEPTH * I_L; it += NGW) {
        const int l = it / I_L; int r = it - l * I_L;
        if (r < I_IN) { const int rb = r >> 4, kb = r & 15; int nv; const int sc = win_src(rb * 32, nv);
            transpose_item(A.w_in + (size_t)l * D * NIN, NIN, D, kb, sc, nv, (bf16_t*)(A.ws + WS_WIN + (size_t)l * 16 * MiB), rb * 32, 1, scr, lane, (rb >= 96 && rb < 128) ? 0.12751743f : 1.0f); continue; }
        r -= I_IN;
        if (r < I_OUT) { transpose_item(A.w_out + (size_t)l * D * D, D, D, r & 15, (r >> 4) * 32, 32, (bf16_t*)(A.ws + WS_WOUT + (size_t)l * 2 * MiB), (r >> 4) * 32, 1, scr, lane); continue; }
        r -= I_OUT;
        if (r < I_1) { transpose_item(A.w_mlp1 + (size_t)l * D * FF, FF, D, r & 15, (r >> 4) * 32, 32, (bf16_t*)(A.ws + WS_W1 + (size_t)l * 8 * MiB), (r >> 4) * 32, 1, scr, lane); continue; }
        r -= I_1;
        if (r < I_2) { transpose_item(A.w_mlp2 + (size_t)l * FF * D, D, FF, r & 63, (r >> 6) * 32, 32, (bf16_t*)(A.ws + WS_W2 + (size_t)l * 8 * MiB), (r >> 6) * 32, 1, scr, lane); continue; }
        r -= I_2;
        { const int mat = r >> 7, g = (r >> 5) & 3, nb = (r >> 2) & 7, kb = r & 3;
          const float* W = (mat ? A.w_rg_x : A.w_rg_a) + ((size_t)l * 4 + g) * 65536;
          transpose_item(W, 256, 256, kb, nb * 32, 32, (bf16_t*)(A.ws + WS_WRG + (size_t)l * MiB) + (size_t)g * 512 * 256, mat * 256 + nb * 32, 1, scr, lane); }
    }
    if (gw == 0) {
        float* lut = (float*)(A.ws + WS_LUT);
        for (int i = lane; i < NH * 128; i += 64) { const int h = i >> 7, d = i & 127;
            lut[i] = (A.rel_bias[t5_bucket(d) * NH + h] - A.rel_bias[31 * NH + h]) * 1.4426950408889634f; }
    }
}

template <int MODE>
__device__ __forceinline__ void phase_rmsnorm(const Args& A, const float* gain, bf16_t* XN, const int wid0, bf16_t* Z0 = nullptr, bf16_t* Z1 = nullptr) {
    const int tid = opaque_tid(wid0), lane = tid & 63, wave = __builtin_amdgcn_readfirstlane(tid >> 6), gw = blockIdx.x * NWAVES + wave, NGW = gridDim.x * NWAVES;
    if (Z0) {
        for (int i = gw; i < 2 * NB * 48; i += NGW) { bf16_t* base = (i & 1) ? Z1 : Z0; const int rr = i >> 1, b = rr / 48, a = 192 + rr % 48; u32x2* o = (u32x2*)(base + ((size_t)b * RA + a) * D) + lane;
#pragma unroll
            for (int j = 0; j < 4; ++j) o[64 * j] = (u32x2){0u, 0u}; } }
    float* hmeta = (float*)(A.ws + WS_HMETA);
    f32x4 gv[4];
#pragma unroll
    for (int j = 0; j < 4; ++j) gv[j] = *((const f32x4*)gain + lane + 64 * j);
    for (int row0 = gw; row0 < R; row0 += 2 * NGW) {
        f32x4 v[2][4]; bool act[2] = {false, false}; float* hp[2] = {nullptr, nullptr};
#pragma unroll
        for (int rr = 0; rr < 2; ++rr) {
            const int row = row0 + rr * NGW;
            if (row >= R) continue;
            const int b = row >= RA ? 1 : 0, a = row - b * RA;
            if (a < PADF) {
                if (MODE != 2) { u32x2* o = (u32x2*)(XN + (size_t)row * D) + lane;
#pragma unroll
                    for (int j = 0; j < 4; ++j) o[64 * j] = (u32x2){0u, 0u}; }
                if (MODE == 0) { f32x4* hz = (f32x4*)hrow(A.out, hmeta, row) + lane;
#pragma unroll
                    for (int j = 0; j < 4; ++j) hz[64 * j] = (f32x4){0.f, 0.f, 0.f, 0.f}; }
                continue;
            }
            if (MODE == 2 && a < 256) continue;
            act[rr] = true; hp[rr] = hrow(A.out, hmeta, row);
            const float* src = hp[rr];
            if (MODE == 0) src = (a < 256) ? A.meta + (size_t)(a - PADF) * D : A.x + ((size_t)(b * SEQ + a - 256) << 10);
#pragma unroll
            for (int j = 0; j < 4; ++j) v[rr][j] = *((const f32x4*)src + lane + 64 * j);
        }
#pragma unroll
        for (int rr = 0; rr < 2; ++rr) {
            if (!act[rr]) continue;
            const int row = row0 + rr * NGW;
            float s = 0.f;
#pragma unroll
            for (int j = 0; j < 4; ++j) s += (v[rr][j].x * v[rr][j].x + v[rr][j].y * v[rr][j].y) + (v[rr][j].z * v[rr][j].z + v[rr][j].w * v[rr][j].w);
            const float rstd = 1.0f / sqrtf(wave_sum(s) * (1.0f / D) + EPS);
            if (MODE == 0 && row - (row >= RA ? RA : 0) < 256) {
#pragma unroll
                for (int j = 0; j < 4; ++j) *((f32x4*)hp[rr] + lane + 64 * j) = v[rr][j]; }
            if (MODE == 2) {
#pragma unroll
                for (int j = 0; j < 4; ++j) *((f32x4*)hp[rr] + lane + 64 * j) = v[rr][j] * rstd * gv[j];
            } else {
                u32x2* o = (u32x2*)(XN + (size_t)row * D) + lane;
#pragma unroll
                for (int j = 0; j < 4; ++j) { const f32x4 y = v[rr][j] * rstd * gv[j]; o[64 * j] = (u32x2){cvt_pk_bf16(y.x, y.y), cvt_pk_bf16(y.z, y.w)}; }
            }
        }
    }
}

__device__ __forceinline__ void phase_conv(const bf16_t* U, bf16_t* XC, const float* cw, const float* cb, int G, const int wid0) {
    const int t_ = opaque_tid(wid0), ch = (t_ & 255) * 4, us = t_ >> 8;
    f32x4 w[4];
#pragma unroll
    for (int j = 0; j < 4; ++j) w[j] = *(const f32x4*)(cw + j * D + ch);
    const f32x4 bb = *(const f32x4*)(cb + ch);
    for (int unit = blockIdx.x * 2 + us; unit < NB * NCHUNK; unit += 2 * G) {
        const int b = unit / NCHUNK, c = unit - b * NCHUNK; const size_t r0 = (size_t)b * RA + c * CHROWS;
        f32x4 x0 = {0.f, 0.f, 0.f, 0.f}, x1 = x0, x2 = x0;
        if (c * CHROWS - 3 >= PADF) { const u32x2 q = *(const u32x2*)(U + (r0 - 3) * D + ch); x0 = (f32x4){bf_lo(q.x), bf_hi(q.x), bf_lo(q.y), bf_hi(q.y)}; }
        if (c * CHROWS - 2 >= PADF) { const u32x2 q = *(const u32x2*)(U + (r0 - 2) * D + ch); x1 = (f32x4){bf_lo(q.x), bf_hi(q.x), bf_lo(q.y), bf_hi(q.y)}; }
        if (c * CHROWS - 1 >= PADF) { const u32x2 q = *(const u32x2*)(U + (r0 - 1) * D + ch); x2 = (f32x4){bf_lo(q.x), bf_hi(q.x), bf_lo(q.y), bf_hi(q.y)}; }
#pragma unroll 5
        for (int i = 0; i < CHROWS; ++i) {
            const size_t off = (r0 + i) * D + ch;
            const bool live = c * CHROWS + i >= PADF;
            f32x4 x3 = {0.f, 0.f, 0.f, 0.f};
            if (live) { const u32x2 q = *(const u32x2*)(U + off); x3 = (f32x4){bf_lo(q.x), bf_hi(q.x), bf_lo(q.y), bf_hi(q.y)}; }
            const f32x4 acc = bb + w[0] * x0 + w[1] * x1 + w[2] * x2 + w[3] * x3;
            u32x2 o = {0u, 0u};
            if (live) { o.x = cvt_pk_bf16(acc.x, acc.y); o.y = cvt_pk_bf16(acc.z, acc.w); }
            *(u32x2*)(XC + off) = o;
            x0 = x1; x1 = x2; x2 = x3;
        }
    }
}

__device__ __forceinline__ float nexpm1_fast(float x) {
    const float e = 1.0f - __expf(x), p = -x * (1.0f + x * (0.5f + x * 0.16666667f));
    return x > -0.01f ? p : e;
}
__device__ __forceinline__ void phase_scan_local(bf16_t* PA, bf16_t* PX, const bf16_t* XC, const float* ba, const float* bx, const float* lam, float* AGG, int G, const bool dry, const int wid0) {
    const int t_ = opaque_tid(wid0), ch = (t_ & 255) * 4, us = t_ >> 8;
    const f32x4 bav = *(const f32x4*)(ba + ch), bxv = *(const f32x4*)(bx + ch), lmv = *(const f32x4*)(lam + ch);
    float sp[4];
#pragma unroll
    for (int k = 0; k < 4; ++k) sp[k] = -8.0f * log1pf(__expf(-lmv[k]));
    for (int unit = blockIdx.x * 2 + us; unit < NB * NCHUNK; unit += 2 * G) {
        const int b = unit / NCHUNK, c = unit - b * NCHUNK; const size_t r0 = (size_t)b * RA + c * CHROWS;
        float Ac[4] = {1.f, 1.f, 1.f, 1.f}, Hc[4] = {0.f, 0.f, 0.f, 0.f};
#pragma unroll 5
        for (int i = 0; i < CHROWS; ++i) {
            const size_t off = (r0 + i) * D + ch;
            const u32x2 pa = *(const u32x2*)(PA + off), px = *(const u32x2*)(PX + off), xc = *(const u32x2*)(XC + off);
            float l[4], v[4];
            l[0] = sigm_fast(bf_lo(pa.x) + bav[0]) * sp[0]; l[1] = sigm_fast(bf_hi(pa.x) + bav[1]) * sp[1]; l[2] = sigm_fast(bf_lo(pa.y) + bav[2]) * sp[2]; l[3] = sigm_fast(bf_hi(pa.y) + bav[3]) * sp[3];
            v[0] = sigm_fast(bf_lo(px.x) + bxv[0]) * bf_lo(xc.x); v[1] = sigm_fast(bf_hi(px.x) + bxv[1]) * bf_hi(xc.x); v[2] = sigm_fast(bf_lo(px.y) + bxv[2]) * bf_lo(xc.y); v[3] = sigm_fast(bf_hi(px.y) + bxv[3]) * bf_hi(xc.y);
            if (c * CHROWS + i < PADF) {
#pragma unroll
                for (int k = 0; k < 4; ++k) { l[k] = 0.f; v[k] = 0.f; } }
            h16x4 lh, vh;
#pragma unroll
            for (int k = 0; k < 4; ++k) { lh[k] = (_Float16)l[k]; vh[k] = (_Float16)v[k]; }
            if (!dry) { *(h16x4*)(PA + off) = lh; *(h16x4*)(PX + off) = vh; }
#pragma unroll
            for (int k = 0; k < 4; ++k) { const float lr = (float)lh[k], vr = (float)vh[k];
                const float ak = __expf(lr); Hc[k] = ak * Hc[k] + __builtin_amdgcn_sqrtf(nexpm1_fast(2.0f * lr)) * vr; Ac[k] *= ak; }
        }
        if (!dry) { *(f32x4*)(AGG + (size_t)unit * D + ch) = (f32x4){Ac[0], Ac[1], Ac[2], Ac[3]};
            *(f32x4*)(AGG + (size_t)(NB * NCHUNK + unit) * D + ch) = (f32x4){Hc[0], Hc[1], Hc[2], Hc[3]}; }
    }
}
__device__ __forceinline__ void phase_scan_carry(const float* AGG, float* CARRY, const int wid0) {
    const int tid = opaque_tid(wid0), lane = tid & 63, wave = __builtin_amdgcn_readfirstlane(tid >> 6), gw = blockIdx.x * NWAVES + wave, NGW = gridDim.x * NWAVES;
    for (int t = gw; t < NB * D; t += NGW) {
        const int b = t >> 10, ch = t & 1023;
        float a[4], hh[4];
#pragma unroll
        for (int i = 0; i < 4; ++i) { const size_t u = (size_t)(b * NCHUNK + 4 * lane + i); a[i] = AGG[u * D + ch]; hh[i] = AGG[((size_t)NB * NCHUNK + u) * D + ch]; }
        float Am = a[0], Bm = hh[0];
#pragma unroll
        for (int i = 1; i < 4; ++i) { Bm = a[i] * Bm + hh[i]; Am *= a[i]; }
#pragma unroll
        for (int off = 1; off < 64; off <<= 1) { const float Ap = __shfl_up(Am, off), Bp = __shfl_up(Bm, off); if (lane >= off) { Bm = Am * Bp + Bm; Am = Am * Ap; } }
        float h = __shfl_up(Bm, 1); if (lane == 0) h = 0.f;
#pragma unroll
        for (int i = 0; i < 4; ++i) { CARRY[(size_t)(b * NCHUNK + 4 * lane + i) * D + ch] = h; h = a[i] * h + hh[i]; }
    }
}
__device__ __forceinline__ float gelu_fast(float x) { const float z = 0.7978845608028654f * (x + 0.044715f * x * x * x); return x * __builtin_amdgcn_rcpf(1.0f + __expf(-2.0f * z)); }
__device__ __forceinline__ void phase_scan_apply(const _Float16* LA, const _Float16* V, const float* CARRY, const bf16_t* UG, const bf16_t* GR, bf16_t* Y, int G, const int wid0) {
    const int t_ = opaque_tid(wid0), ch = (t_ & 255) * 4, us = t_ >> 8;
    for (int unit = blockIdx.x * 2 + us; unit < NB * NCHUNK; unit += 2 * G) {
        const int b = unit / NCHUNK, c = unit - b * NCHUNK; const size_t r0 = (size_t)b * RA + c * CHROWS;
        const f32x4 hc = *(const f32x4*)(CARRY + (size_t)unit * D + ch);
        float Hc[4] = {hc.x, hc.y, hc.z, hc.w};
#pragma unroll 5
        for (int i = 0; i < CHROWS; ++i) {
            const size_t off = (r0 + i) * D + ch;
            const h16x4 la = *(const h16x4*)(LA + off), vv = *(const h16x4*)(V + off);
            const u32x2 ug = *(const u32x2*)(UG + off), gr = *(const u32x2*)(GR + off);
            const float ugf[4] = {bf_lo(ug.x), bf_hi(ug.x), bf_lo(ug.y), bf_hi(ug.y)}, grf[4] = {bf_lo(gr.x), bf_hi(gr.x), bf_lo(gr.y), bf_hi(gr.y)};
            float y[4];
#pragma unroll
            for (int k = 0; k < 4; ++k) { const float lr = (float)la[k]; const float ak = __expf(lr);
                Hc[k] = ak * Hc[k] + __builtin_amdgcn_sqrtf(nexpm1_fast(2.0f * lr)) * (float)vv[k];
                y[k] = Hc[k] * gelu_fast(ugf[k]) * sigm_fast(grf[k]); }
            if (c * CHROWS + i < PADF) { y[0] = 0.f; y[1] = 0.f; y[2] = 0.f; y[3] = 0.f; }
            *(u32x2*)(Y + off) = (u32x2){cvt_pk_bf16(y[0], y[1]), cvt_pk_bf16(y[2], y[3])};
        }
    }
}


constexpr int IDX_KBUF = 65536, IDX_TAB = 131072, IDX_CAP = 16, IDX_DB = 9, IDX_OVF = 2048, IDX_TMP = 1024;
__device__ __forceinline__ unsigned mono_key(float s) { const unsigned v = __float_as_uint(s); return v ^ ((unsigned)((int)v >> 31) | 0x80000000u); }
__device__ __forceinline__ unsigned qb_bin(float v) { const unsigned bits = __float_as_uint(v); int f = (int)((bits >> 21) & 0x3ffu) - 444; f = f < 0 ? 0 : (f > 255 ? 255 : f); return (bits >> 31) ? (unsigned)(255 - f) : (unsigned)(256 + f); }
__device__ __forceinline__ float qb_edge(int f) { return f <= 0 ? 0.f : __uint_as_float((unsigned)(f + 444) << 21); }
__device__ __forceinline__ float qb_lo(unsigned b) { return b >= 256u ? qb_edge((int)b - 256) : -qb_edge(256 - (int)b); }
__device__ __forceinline__ float qb_hi(unsigned b) { return b >= 256u ? qb_edge((int)b - 255) : -qb_edge(255 - (int)b); }
__device__ __forceinline__ float inv_mono_key(unsigned k) { return __uint_as_float((k & 0x80000000u) ? (k ^ 0x80000000u) : ~k); }
__device__ __forceinline__ float bin_threshold(float target, float wsc, float wof) {
    unsigned k = mono_key((target - wof) / wsc);
    for (int i = 0; i < 64 && fmaf(inv_mono_key(k - 1u), wsc, wof) >= target; ++i) --k;
    for (int i = 0; i < 64 && !(fmaf(inv_mono_key(k), wsc, wof) >= target); ++i) ++k;
    return inv_mono_key(k);
}
__device__ __forceinline__ unsigned long long* mask_chunk(unsigned long long* MASK, int b, int qblk, int j) { return MASK + ((size_t)b * MASK_CHUNKS_PER_BATCH + 2 * qblk * (qblk + 1) + j) * 256; }

constexpr int IDX_WB = 256;
template <int MODE>
__device__ __forceinline__ void idx_sweep(LAS unsigned char* lds, const bf16_t* KIb, const bf16x8 (&qf)[8][2], const bf16x8 (&qs)[2][2], const float (&cs)[8], const int u, const int tid, const unsigned pfx, const int a_q, const unsigned Wq, unsigned long long* mrow, const int stride, const int shift, const float wlo, const float whi, const float wsc, const float wof, unsigned long long* gbuf) {
    const int lane = tid & 63, wid = __builtin_amdgcn_readfirstlane(tid >> 6), q16 = lane & 15, g = lane >> 4, qg = wid & 3, ksp = wid >> 2;
    const int nsteps = (u >> 2) + 1;
    const bf16_t* gsrc = KIb + (size_t)(tid >> 3) * IDIM + (((tid & 7) ^ ((tid >> 4) & 7)) << 3);
    LAS unsigned char* kb = lds + IDX_KBUF;
    const unsigned dma_off = (unsigned)wid * 1024u;
    const int sw = (q16 >> 1) & 7;
    const int kaddr0 = q16 * 128 + ((g ^ sw) << 4), kaddr1 = q16 * 128 + (((g + 4) ^ sw) << 4);
    LAS unsigned* hist = (LAS unsigned*)lds;
    const int qrow = 16 * qg + q16, hrow_ = qrow * 256, hx = qrow & 31;
    unsigned ccount = 0u; const int csub = qrow * 8 + ksp * 4 + g;
    unsigned above = 0u;
    float f_lo = 0.f, f_hi = 0.f;
    if (MODE == 4) { if (pfx == 0xFFFFFFFFu) { f_hi = -3.402823466e38f; f_lo = f_hi; } else { f_lo = inv_mono_key(pfx << shift); f_hi = inv_mono_key((pfx + 1u) << shift); } }
    float t_sel = -3.402823466e38f, t_cand = -3.402823466e38f;
    if (MODE == 7 && wsc > 0.f) { t_cand = bin_threshold((float)((int)pfx + 1), wsc, wof); t_sel = bin_threshold((float)((int)pfx + 2), wsc, wof); }
#pragma unroll
    for (int i = 0; i < 4; ++i) __builtin_amdgcn_global_load_lds((const unsigned*)(gsrc + (size_t)(64 * i) * IDIM), (LAS unsigned*)(kb + i * 8192 + dma_off), 16, 0, 0);
    asm volatile("s_waitcnt vmcnt(0)" ::: "memory");
    __syncthreads();
    for (int s = 0, it = 0; s < nsteps; s += stride, ++it) {
        const bool more = s + stride < nsteps;
        if (more) {
#pragma unroll
            for (int i = 0; i < 4; ++i) __builtin_amdgcn_global_load_lds((const unsigned*)(gsrc + (size_t)(256 * (s + stride) + 64 * i) * IDIM), (LAS unsigned*)(kb + ((it + 1) & 1) * 32768 + i * 8192 + dma_off), 16, 0, 0); }
#pragma unroll
        for (int tt = 0; tt < 2; ++tt) {
            const int t = 4 * s + 2 * ksp + tt;
            const LAS unsigned char* kt = kb + (it & 1) * 32768 + (2 * ksp + tt) * 8192;
            if (t >= 3 && t <= u) {
                const bool edge = (t == u) || (t == 3);
                f32x4 sc[4];
                {
                    bf16x8 kf[4][2];
#pragma unroll
                    for (int bk = 0; bk < 4; ++bk) { kf[bk][0] = *(const LAS bf16x8*)(kt + kaddr0 + bk * 2048); kf[bk][1] = *(const LAS bf16x8*)(kt + kaddr1 + bk * 2048); }
                    const f32x4 z4 = {0.f, 0.f, 0.f, 0.f};
                    f32x4 a_cur = __builtin_amdgcn_mfma_f32_16x16x32_bf16(kf[0][0], qs[0][0], z4, 0, 0, 0), a_done = z4, sv = z4;
#pragma unroll
                    for (int j = 0; j <= 36; ++j) {
                        f32x4 a_nxt = z4, b_ = z4;
                        if (j < 36) {
                            if (j + 1 < 36) { const int bk1 = (j + 1) / 9, j1 = (j + 1) % 9; a_nxt = __builtin_amdgcn_mfma_f32_16x16x32_bf16(kf[bk1][0], j1 == 0 ? qs[0][0] : qf[j1 == 0 ? 0 : j1 - 1][0], z4, 0, 0, 0); }
                            const int bk = j / 9, jj = j % 9;
                            b_ = __builtin_amdgcn_mfma_f32_16x16x32_bf16(kf[bk][1], jj == 0 ? qs[0][1] : qf[jj == 0 ? 0 : jj - 1][1], a_cur, 0, 0, 0);
                        }
                        __builtin_amdgcn_sched_barrier(0);
                        if (j >= 1) { const int bkp = (j - 1) / 9, jp = (j - 1) % 9;
                            if (jp == 0) sv = a_done;
                            else {
#pragma unroll
                                for (int r = 0; r < 4; ++r) { sv[r] = fmaf(__builtin_fabsf(a_done[r]), cs[jp - 1], sv[r]); asm volatile("" : "+v"(sv[r])); }
                            }
                            if (jp == 8) sc[bkp] = sv; }
                        __builtin_amdgcn_sched_barrier(0);
                        a_done = b_; a_cur = a_nxt;
                    }
                }
                if (edge) {
                    const int dq = a_q - 64 * t - 4 * g;
#pragma unroll
                    for (int bk = 0; bk < 4; ++bk)
#pragma unroll
                        for (int r = 0; r < 4; ++r) { if ((unsigned)(dq - (16 * bk + r)) >= Wq) sc[bk][r] = -__builtin_inff(); }
                }
                if (MODE == 6) {
                    const unsigned rb = (unsigned)(uintptr_t)(hist + hrow_) - 4u; unsigned one_ = 1u; asm volatile("" : "+v"(one_));
#pragma unroll
                    for (int bk = 0; bk < 4; ++bk)
#pragma unroll
                        for (int r = 0; r < 4; ++r) { int t = (int)fmaf(sc[bk][r], wsc, wof); t = t < IDX_WB ? t : IDX_WB;
                            const unsigned addr = ((unsigned)t << 2) + rb;
                            unsigned long long sv_;
                            asm volatile("v_cmp_lt_i32 vcc, 0, %2\n\ts_and_saveexec_b64 %0, vcc\n\tds_add_u32 %1, %3\n\ts_mov_b64 exec, %0" : "=&s"(sv_) : "v"(addr), "v"(t), "v"(one_) : "vcc", "memory");
                        }
                } else if (MODE == 5) {
#pragma unroll
                    for (int bk = 0; bk < 4; ++bk)
#pragma unroll
                        for (int r = 0; r < 4; ++r) { const unsigned bin = qb_bin(sc[bk][r]);
                            __hip_atomic_fetch_add(hist + hrow_ + ((bin >> 1) ^ hx), (bin & 1u) ? 65536u : 1u, __ATOMIC_RELAXED, __HIP_MEMORY_SCOPE_WORKGROUP); }
                } else if (MODE < 3) {
#pragma unroll
                    for (int bk = 0; bk < 4; ++bk)
#pragma unroll
                        for (int r = 0; r < 4; ++r) {
                            const unsigned key = mono_key(sc[bk][r]);
                            const bool match = (MODE == 0) ? true : ((key >> ((32 - IDX_DB * MODE) & 31)) == pfx);
                            if (match) { const unsigned bin = (key >> (32 - IDX_DB - IDX_DB * MODE)) & 511u;
                                __hip_atomic_fetch_add(hist + hrow_ + ((bin >> 1) ^ hx), (bin & 1u) ? 65536u : 1u, __ATOMIC_RELAXED, __HIP_MEMORY_SCOPE_WORKGROUP); }
                        }
                } else {
                    unsigned wlo_ = 0u, whi_ = 0u;
                    if (MODE == 3) {
#pragma unroll
                        for (int bk = 0; bk < 4; ++bk)
#pragma unroll
                            for (int r = 0; r < 4; ++r) { if (mono_key(sc[bk][r]) >= pfx) { if (bk < 2) wlo_ |= 1u << (16 * bk + r); else whi_ |= 1u << (16 * (bk - 2) + r); } }
                    } else {
                        unsigned cm = 0u;
#pragma unroll
                        for (int bk = 0; bk < 4; ++bk)
#pragma unroll
                            for (int r = 0; r < 4; ++r) { const float v = sc[bk][r];
                                if (MODE == 7) continue;
                                const bool selv = v >= f_hi, candv = !selv && v >= f_lo;
                                if (selv) { if (bk < 2) wlo_ |= 1u << (16 * bk + r); else whi_ |= 1u << (16 * (bk - 2) + r); }
                                else if (candv) cm |= 1u << (4 * bk + r); }
                        if (MODE == 7) {
                            unsigned selw = 0u; const int p1 = (int)pfx + 1;
#pragma unroll
                            for (int e = 15; e >= 0; --e)
                                asm volatile("v_cmp_ge_f32 vcc, %2, %3\n\tv_addc_co_u32 %0, vcc, %0, %0, vcc\n\tv_cmp_ge_f32 vcc, %2, %4\n\tv_addc_co_u32 %1, vcc, %1, %1, vcc" : "+v"(selw), "+v"(cm) : "v"(sc[e >> 2][e & 3]), "v"(t_sel), "v"(t_cand) : "vcc");
                            cm &= ~selw; (void)p1;
                            wlo_ = (selw & 0xFu) | ((selw & 0xF0u) << 12); whi_ = ((selw >> 8) & 0xFu) | ((selw & 0xF000u) << 4);
                        }
                        if (__any(cm != 0u)) {
                            LAS unsigned long long* clist = (LAS unsigned long long*)lds + (size_t)csub * IDX_CAP;
#pragma unroll
                            for (int bk = 0; bk < 4; ++bk) { if (__any((cm >> (4 * bk)) & 15u)) {
#pragma unroll
                                for (int r = 0; r < 4; ++r) { if (cm & (1u << (4 * bk + r))) {
                                    const unsigned long long e_ = ((unsigned long long)__float_as_uint(sc[bk][r]) << 32) | (unsigned)(64 * t + 16 * bk + 4 * g + r);
                                    if (ccount < (unsigned)IDX_CAP) clist[ccount] = e_;
                                    else { const unsigned sl = __hip_atomic_fetch_add((LAS unsigned*)(lds + IDX_TAB) + 195, 1u, __ATOMIC_RELAXED, __HIP_MEMORY_SCOPE_WORKGROUP);
                                        if (sl < (unsigned)IDX_OVF) { gbuf[2 * sl] = (unsigned long long)qrow; gbuf[2 * sl + 1] = e_; } }
                                    ++ccount; } } } }
                        }
                    }
                    wlo_ <<= 4 * g; whi_ <<= 4 * g;
                    wlo_ |= __shfl_xor(wlo_, 16); whi_ |= __shfl_xor(whi_, 16); wlo_ |= __shfl_xor(wlo_, 32); whi_ |= __shfl_xor(whi_, 32);
                    if (g == 0) mrow[(size_t)t * 256] = ((unsigned long long)whi_ << 32) | wlo_;
                }
            } else if (MODE >= 3 && t > u) {
                if (g == 0) mrow[(size_t)t * 256] = 0ull;
            }
        }
        asm volatile("s_waitcnt vmcnt(0)" ::: "memory");
        __syncthreads();
    }
    if (MODE == 4 || MODE == 7) ((LAS unsigned*)(lds + IDX_TAB) + 256)[csub] = ccount;
    if (MODE == 6) asm volatile("s_waitcnt lgkmcnt(0)" ::: "memory");
}

constexpr unsigned IDX_ZOOM = 900u;
template <int FM>
__device__ __forceinline__ void idx_find(LAS unsigned char* lds, int tid, int u, bool exact) {
    const int lane = tid & 63, wid = __builtin_amdgcn_readfirstlane(tid >> 6);
    LAS unsigned* hist = (LAS unsigned*)lds; LAS unsigned* ptab = (LAS unsigned*)(lds + IDX_TAB); LAS unsigned* rtab = ptab + 64; LAS unsigned* atab = ptab + 128; LAS unsigned* ftab = ptab + 192; LAS float* wtab = (LAS float*)(ptab + 768);
    for (int i = 0; i < 8; ++i) {
        const int q = 8 * wid + i;
        unsigned c[8]; unsigned T = 0u;
#pragma unroll
        for (int k = 0; k < 4; ++k) { LAS unsigned* pp = hist + q * 256 + ((4 * lane + k) ^ (FM == 2 ? 0 : (q & 31)));     const unsigned d = *pp; *pp = 0u; c[2 * k] = FM == 2 ? d : (d & 0xffffu); c[2 * k + 1] = FM == 2 ? 0u : (d >> 16); T += c[2 * k] + c[2 * k + 1]; }
        unsigned x = T;
#pragma unroll
        for (int off = 1; off < 64; off <<= 1) { const unsigned y = __shfl_down(x, off); if (lane + off < 64) x += y; }
        const unsigned total = (unsigned)__shfl((int)x, 0);
        const int Wq = 64 * u + q - PADF + 1;
        if (Wq <= 256) { if (FM == 1 && lane == 0) { wtab[q] = -3.0e38f; wtab[64 + q] = -3.0e38f; wtab[128 + q] = 0.f; wtab[192 + q] = 1000.f; } continue; }
        unsigned rank = 256u, rank2 = 256u;
        LAS unsigned* stab = (LAS unsigned*)(lds + MISC_OFF + 2048);
        if (FM == 1 && !exact) { const unsigned rs = (unsigned)((256ull * total + (unsigned)Wq / 2) / (unsigned)Wq); if (lane == 0) stab[q] = rs;
            rank = rs / 2 > 3u ? rs / 2 - 3u : 1u; rank2 = 2u * rs + 8u; if (rank2 > total) rank2 = total; if (rank2 < 1u) rank2 = 1u; }
        if (FM == 3) {
            const unsigned rs = stab[q], ab = atab[q]; const unsigned r1 = rs / 2 > 3u ? rs / 2 - 3u : 1u, r2 = 2u * rs + 8u;
            rank = r1 > ab ? r1 - ab : 0u; rank2 = r2 > ab ? r2 - ab : 1u; if (rank2 > total) rank2 = total; if (rank2 < 1u) rank2 = 1u; }
        if (FM == 2) { if (total < 256u) { if (lane == 0) ftab[1] = 1u; continue; } }
        const unsigned ab0 = x - T;
        unsigned ab = ab0; int sel = -1; unsigned above = 0u, cb = 0u;
#pragma unroll
        for (int k = 7; k >= 0; --k) { if (sel < 0 && ab < rank && rank <= ab + c[k]) { sel = k; above = ab; cb = c[k]; } ab += c[k]; }
        const unsigned long long bal = __ballot(sel >= 0);
        unsigned bstar = 0u, nrank = rank, cbin = 0u;
        if (bal) { const int L = __ffsll((long long)bal) - 1; bstar = 8u * (unsigned)L + (unsigned)__shfl(sel, L); nrank = rank - (unsigned)__shfl((int)above, L); cbin = (unsigned)__shfl((int)cb, L); }
        if (FM == 2) bstar >>= 1;
        if (FM == 2 && (!bal || bstar == (unsigned)IDX_WB - 1u)) { if (lane == 0) ftab[1] = 1u; continue; }
        if (FM == 1 || FM == 3) {
            ab = ab0; int sel2 = -1;
#pragma unroll
            for (int k = 7; k >= 0; --k) { if (sel2 < 0 && ab < rank2 && rank2 <= ab + c[k]) sel2 = k; ab += c[k]; }
            const unsigned long long bal2 = __ballot(sel2 >= 0);
            unsigned bbot = bstar; if (bal2) { const int L2 = __ffsll((long long)bal2) - 1; bbot = 8u * (unsigned)L2 + (unsigned)__shfl(sel2, L2); }
            if (lane == 0) {
                if (FM == 1) { if (bbot > bstar) bbot = bstar;
                    const float lo = qb_lo(bbot), hi = qb_hi(bstar), scale = (float)(IDX_WB - 1) / (hi - lo);
                    wtab[q] = lo; wtab[64 + q] = hi; wtab[128 + q] = scale; wtab[192 + q] = -lo * scale + 1.0f; }
                else {
                    const float lo0 = wtab[q], hi0 = wtab[64 + q], w = 1.0f / wtab[128 + q];
                    unsigned btop = (rank == 0u || !bal) ? 511u : bstar; if (bbot > btop) bbot = btop;
                    float lo = lo0 + (float)bbot * w, hi = (btop >= 511u) ? hi0 : lo0 + (float)(btop + 1u) * w;
                    if (!(hi > lo)) { lo = lo0; hi = hi0; }
                    const float scale = 512.0f / (hi - lo);
                    wtab[q] = lo; wtab[64 + q] = hi; wtab[128 + q] = scale; wtab[192 + q] = -lo * scale + 1.0f; }
            }
        }
        if (FM == 2 && lane == 0) {
            ptab[q] = bstar; rtab[q] = nrank;
            LAS float* ztab = (LAS float*)(lds + MISC_OFF + 1024);
            ztab[128 + q] = 0.f;
            if (cbin > 8u) {
                const float lo = wtab[q], sc = wtab[128 + q], w = 1.0f / sc;
                const float nlo = lo + ((float)bstar - 1.0f) * w, nhi = lo + ((float)bstar + 2.0f) * w;
                if (nhi > nlo) { const float ns = (float)(IDX_WB - 1) / (nhi - nlo);
                    if (cbin > IDX_ZOOM) { wtab[q] = nlo; wtab[64 + q] = nhi; wtab[128 + q] = ns; wtab[192 + q] = -nlo * ns + 1.0f; ftab[2] = 1u; }
                    else { ztab[q] = nlo; ztab[64 + q] = nhi; ztab[128 + q] = ns; ztab[192 + q] = -nlo * ns + 1.0f; } }
            }
        }
    }
}

__device__ __forceinline__ void idx_unit(LAS unsigned char* lds, const bf16_t* QI, const bf16_t* KI, const float* WI, unsigned long long* MASK, const int b, const int u, const int tid) {
    const int lane = tid & 63, wid = __builtin_amdgcn_readfirstlane(tid >> 6), q16 = lane & 15, g = lane >> 4, qg = wid & 3;
    const int a_q = 64 * u + 16 * qg + q16; const size_t row = (size_t)b * RA + a_q;
    const unsigned Wq = a_q >= PADF ? (unsigned)(a_q - PADF + 1) : 0u;
    LAS unsigned* ptab = (LAS unsigned*)(lds + IDX_TAB); LAS unsigned* rtab = ptab + 64;
    for (int i = tid; i < 16384; i += NTHREADS) ((LAS unsigned*)lds)[i] = 0u;
    if (tid < 64) { ptab[tid] = 0u; rtab[tid] = 256u; }
    bf16x8 qf[8][2]; bf16x8 qs[2][2]; float cs[8];
    float qsum[2][8];
#pragma unroll
    for (int ks = 0; ks < 2; ++ks)
#pragma unroll
        for (int j = 0; j < 8; ++j) qsum[ks][j] = 0.f;
#pragma unroll
    for (int h = 0; h < 8; ++h) {
        const float w = WI[row * 8 + h];
        cs[h] = w > 0.f ? 1.f : (w < 0.f ? -1.f : 0.f);
#pragma unroll
        for (int ks = 0; ks < 2; ++ks) {
            const u32x4 raw = *(const u32x4*)(QI + row * 512 + h * 64 + ks * 32 + g * 8);
            u32x4 o; o.x = cvt_pk_bf16(bf_lo(raw.x) * w, bf_hi(raw.x) * w); o.y = cvt_pk_bf16(bf_lo(raw.y) * w, bf_hi(raw.y) * w);
            o.z = cvt_pk_bf16(bf_lo(raw.z) * w, bf_hi(raw.z) * w); o.w = cvt_pk_bf16(bf_lo(raw.w) * w, bf_hi(raw.w) * w);
            qf[h][ks] = *reinterpret_cast<bf16x8*>(&o);
            qsum[ks][0] += bf_lo(o.x); qsum[ks][1] += bf_hi(o.x); qsum[ks][2] += bf_lo(o.y); qsum[ks][3] += bf_hi(o.y);
            qsum[ks][4] += bf_lo(o.z); qsum[ks][5] += bf_hi(o.z); qsum[ks][6] += bf_lo(o.w); qsum[ks][7] += bf_hi(o.w);
        }
    }
#pragma unroll
    for (int ks = 0; ks < 2; ++ks) {
        u32x4 hi, lo;
        { const unsigned hw = cvt_pk_bf16(qsum[ks][0], qsum[ks][1]); hi.x = hw; lo.x = cvt_pk_bf16(qsum[ks][0] - bf_lo(hw), qsum[ks][1] - bf_hi(hw)); }
        { const unsigned hw = cvt_pk_bf16(qsum[ks][2], qsum[ks][3]); hi.y = hw; lo.y = cvt_pk_bf16(qsum[ks][2] - bf_lo(hw), qsum[ks][3] - bf_hi(hw)); }
        { const unsigned hw = cvt_pk_bf16(qsum[ks][4], qsum[ks][5]); hi.z = hw; lo.z = cvt_pk_bf16(qsum[ks][4] - bf_lo(hw), qsum[ks][5] - bf_hi(hw)); }
        { const unsigned hw = cvt_pk_bf16(qsum[ks][6], qsum[ks][7]); hi.w = hw; lo.w = cvt_pk_bf16(qsum[ks][6] - bf_lo(hw), qsum[ks][7] - bf_hi(hw)); }
        qs[0][ks] = *reinterpret_cast<bf16x8*>(&hi); qs[1][ks] = *reinterpret_cast<bf16x8*>(&lo);
    }
    const bf16_t* KIb = KI + (size_t)b * RA * IDIM;
    unsigned long long* mrow = mask_chunk(MASK, b, u >> 2, 0) + (size_t)(64 * (u & 3) + 16 * qg + q16);
    __syncthreads();
    LAS unsigned* ccnt = ptab + 256; LAS unsigned* oflag = ptab + 192; LAS unsigned* wfail = ptab + 193; LAS unsigned* zflag = ptab + 194; LAS unsigned* atab = ptab + 128; LAS float* wtab = (LAS float*)(ptab + 768);
    const int u0 = u; const bf16_t* KIb0 = KIb;
    unsigned long long* gbuf = (unsigned long long*)((unsigned char*)MASK - WS_A0 + WS_AGG) + (size_t)blockIdx.x * (2 * IDX_OVF);
    LAS unsigned* ovfc = ptab + 195;
    int stage = (u0 >= 32) ? 0 : 1, zooms = 0; bool have_window = false;
    const int sstride = (u0 >= 96) ? 8 : 4;
    for (;;) {
        int u = u0; GAS const bf16_t* KIbg_ = (GAS const bf16_t*)KIb0; asm volatile("" : "+s"(u), "+s"(KIbg_)); const bf16_t* KIb = (const bf16_t*)KIbg_;
        if (tid < 64) atab[tid] = 0u; if (tid == 64) { *oflag = 0u; *wfail = 0u; *zflag = 0u; *ovfc = 0u; }
        __syncthreads();
        int pass = have_window ? 2 : 0;
        if (pass == 0) {
            idx_sweep<5>(lds, KIb, qf, qs, cs, u, tid, 0u, a_q, Wq, mrow, stage == 0 ? sstride : 1, 0, 0.f, 0.f, 0.f, 0.f, gbuf);
            idx_find<1>(lds, tid, u, stage != 0); __syncthreads();
            pass = 2;
        }
        float wlo, whi, wsc, wof;
        for (;;) {
            wlo = wtab[16 * qg + q16]; whi = wtab[64 + 16 * qg + q16]; wsc = wtab[128 + 16 * qg + q16]; wof = wtab[192 + 16 * qg + q16];
            idx_sweep<6>(lds, KIb, qf, qs, cs, u, tid, 0u, a_q, Wq, mrow, pass == 1 ? 4 : 1, 0, wlo, whi, wsc, wof, gbuf);
            __syncthreads();
            if (pass == 2) break;
            idx_find<3>(lds, tid, u, false); __syncthreads();
            if (tid < 64) atab[tid] = 0u;
            __syncthreads();
            pass = 2;
        }
        idx_find<2>(lds, tid, u, false); __syncthreads();
        if (*wfail) { if (stage == 0) { stage = 1; have_window = false; __syncthreads(); continue; } }
        else if (*zflag && zooms < 3) { ++zooms; have_window = true; __syncthreads(); continue; }
        idx_sweep<7>(lds, KIb, qf, qs, cs, u, tid, ptab[16 * qg + q16], a_q, Wq, mrow, 1, 0, wlo, whi, wsc, wof, gbuf);
        __syncthreads();
        {
            LAS unsigned long long* clist = (LAS unsigned long long*)lds;
            LAS unsigned long long* tmpw = (LAS unsigned long long*)(lds + IDX_KBUF) + wid * IDX_TMP;
            const unsigned novf = *ovfc < (unsigned)IDX_OVF ? *ovfc : (unsigned)IDX_OVF;
            for (int i = 0; i < 8; ++i) {
                const int q = 8 * wid + i; const unsigned need = rtab[q];
                if (64 * u + q - PADF + 1 <= 256) continue;
                const int sub = q * 8 + (lane >> 3), slot = lane & 7; unsigned c = ccnt[sub]; c = c > (unsigned)IDX_CAP ? (unsigned)IDX_CAP : c;
                const bool v0 = (unsigned)slot < c, v1 = (unsigned)(slot + 8) < c;
                const unsigned long long e0 = v0 ? clist[sub * IDX_CAP + slot] : 0ull, e1 = v1 ? clist[sub * IDX_CAP + slot + 8] : 0ull;
                const unsigned long long bal0 = __ballot(v0), bal1 = __ballot(v1); const int n0 = __popcll(bal0); int n = n0 + __popcll(bal1);
                if (v0) tmpw[(int)__builtin_amdgcn_mbcnt_hi((unsigned)(bal0 >> 32), __builtin_amdgcn_mbcnt_lo((unsigned)bal0, 0u))] = e0;
                if (v1) tmpw[n0 + (int)__builtin_amdgcn_mbcnt_hi((unsigned)(bal1 >> 32), __builtin_amdgcn_mbcnt_lo((unsigned)bal1, 0u))] = e1;
                for (unsigned j0 = 0; j0 < novf; j0 += 64) {
                    const unsigned j = j0 + lane; const bool vq = j < novf && gbuf[2 * j] == (unsigned long long)q;
                    const unsigned long long bq = __ballot(vq);
                    if (vq) { const int idx = n + (int)__builtin_amdgcn_mbcnt_hi((unsigned)(bq >> 32), __builtin_amdgcn_mbcnt_lo((unsigned)bq, 0u)); if (idx < IDX_TMP) tmpw[idx] = gbuf[2 * j + 1]; }
                    n += __popcll(bq);
                }
                if (n > IDX_TMP) n = IDX_TMP;
                if (n == 0) continue;
                asm volatile("s_waitcnt lgkmcnt(0)" ::: "memory");
                for (int c0 = 0; c0 < n; c0 += 64) {
                    const bool va = c0 + lane < n; const unsigned long long ea = va ? tmpw[c0 + lane] : 0ull;
                    const float sa = __uint_as_float((unsigned)(ea >> 32)); const unsigned pa = (unsigned)ea;
                    unsigned ra = 0u;
                    for (int j = 0; j < n; ++j) { const unsigned long long ej = tmpw[j]; const float sj = __uint_as_float((unsigned)(ej >> 32)); const unsigned pj = (unsigned)ej; ra += (sj > sa || (sj == sa && pj < pa)) ? 1u : 0u; }
                    if (va && ra < need) atomicOr(mask_chunk(MASK, b, u >> 2, (int)(pa >> 6)) + (64 * (u & 3) + q), 1ull << (pa & 63u));
                }
                asm volatile("s_waitcnt lgkmcnt(0)" ::: "memory");
            }
        }
        __syncthreads();
        break;
    }
}
__device__ __forceinline__ int queue_pop(unsigned* ctr, volatile LAS unsigned* slot, int tid) {
    if (tid == 0) *slot = __hip_atomic_fetch_add(ctr, 1u, __ATOMIC_RELAXED, __HIP_MEMORY_SCOPE_AGENT);
    __syncthreads();
    const int v = (int)*slot;
    __syncthreads();
    return v;
}
__device__ __forceinline__ void phase_indexer(LAS unsigned char* lds, const bf16_t* QI, const bf16_t* KI, const float* WI, unsigned long long* MASK, unsigned* ctr, const int wid0) {
    constexpr int NITEM = 2 * 257;
    volatile LAS unsigned* slot = (volatile LAS unsigned*)(lds + MISC_OFF) + 16;
    for (;;) {
        const int tid = opaque_tid(wid0);
        const int i = queue_pop(ctr, slot, tid);
        if (i >= NITEM) break;
        idx_unit(lds, QI, KI, WI, MASK, i & 1, 259 - (i >> 1), opaque_tid(wid0));
        __syncthreads();
    }
}


namespace att {
constexpr int NW = 8, QBLK = 32, KVBLK = 64, QB = NW * QBLK, RS = 1024;
constexpr int SHM_V = KVBLK * HD * 2, SHM_K = KVBLK * HD * 2;
constexpr int WS_OFF = 2 * SHM_V + 2 * SHM_K, LUT_OFF = WS_OFF + NW * 64 * 4, EPI_OFF = 69632;
constexpr float SCALE = 0.08838834764831845f;
constexpr float THR = 8.f;
#define KSWZ(row, colB) ((row) * 256 + ((colB) ^ (((row) & 7) << 4)))
#define SBAR() __builtin_amdgcn_sched_barrier(0)
__device__ __forceinline__ int v_st(int k, int c) { const int kk = (k & ~0xC) | ((k & 4) << 1) | ((k & 8) >> 1); return ((kk >> 3) * 4 + (c >> 5)) * 512 + ((kk & 7) * 32 + (c & 31)) * 2; }
__device__ __forceinline__ int v_rd_base(int lane) { return ((lane & 3) << 3) | (((lane >> 2) & 3) << 6) | (((lane >> 4) & 1) << 5) | (((lane >> 5) & 1) << 8); }
constexpr int v_rd_off(int d0, int ks, int half) { return d0 * 512 + ks * 4096 + half * 2048; }
__device__ __forceinline__ int crow(int r, int hi) { return (r & 3) + 8 * (r >> 2) + 4 * hi; }
__device__ __forceinline__ bf16x8 load8(const bf16_t* p) { return *reinterpret_cast<const bf16x8*>(p); }

__device__ __forceinline__ void mask_tile(f32x16& p0, f32x16& p1, unsigned long long mw, int hi) {
    const unsigned long long sh = mw >> (4 * hi);
    const int lo = (int)(unsigned)sh, hh = (int)(unsigned)(sh >> 32);
    const int NEG = (int)0xff800000u;
#pragma unroll
    for (int r = 0; r < 16; ++r) {
        const int c = (r & 3) + 8 * (r >> 2);
        const int m0 = __builtin_amdgcn_sbfe(lo, c, 1), m1 = __builtin_amdgcn_sbfe(hh, c, 1);
        float q0 = p0[r], q1 = p1[r];
        asm("v_bfi_b32 %0, %1, %0, %2" : "+v"(q0) : "v"(m0), "s"(NEG));
        asm("v_bfi_b32 %0, %1, %0, %2" : "+v"(q1) : "v"(m1), "s"(NEG));
        p0[r] = q0; p1[r] = q1;
    }
}
__device__ __forceinline__ void bias_tile(f32x16& p0, f32x16& p1, int dq, const float* lut) {
#pragma unroll
    for (int r = 0; r < 16; ++r) {
        const int c = (r & 3) + 8 * (r >> 2);
        const unsigned d0 = (unsigned)(dq - c), d1 = (unsigned)(dq - c - 32);
        p0[r] += lut[d0 < 127u ? d0 : 127u]; p1[r] += lut[d1 < 127u ? d1 : 127u];
    }
}
__device__ __forceinline__ float max3_s(float a, float b, float c) { float d; asm("v_max3_f32 %0, %1, %2, %3" : "=v"(d) : "v"(a), "v"(b), "v"(c)); return d; }
__device__ __forceinline__ float max2_s(float a, float b) { float d; asm("v_max_f32 %0, %1, %2" : "=v"(d) : "v"(a), "v"(b)); return d; }
__device__ __forceinline__ float max2_s_pl(float a, float b) { float d; asm("v_max_f32 %0, %1, %2\n\ts_nop 1" : "=v"(d) : "v"(a), "v"(b)); return d; }
constexpr float THRL = THR * 1.4426950408889634f;
__device__ __forceinline__ void partialSM(f32x16& p0, f32x16& p1, float& m_ref, f32x16& minit, float& alpha) {
    float pmax = max3_s(p0[0], p0[1], p0[2]);
#pragma unroll
    for (int r = 3; r + 1 < 16; r += 2) pmax = max3_s(pmax, p0[r], p0[r + 1]);
    pmax = max3_s(pmax, p0[15], p1[0]);
#pragma unroll
    for (int r = 1; r + 1 < 16; r += 2) pmax = max3_s(pmax, p1[r], p1[r + 1]);
    pmax = max2_s_pl(pmax, p1[15]);
    { auto rr = __builtin_amdgcn_permlane32_swap(__float_as_uint(pmax), __float_as_uint(pmax), false, false);
      pmax = max2_s(__uint_as_float(rr[0]), __uint_as_float(rr[1])); }
    alpha = 1.f;
    if (!__builtin_expect(__all(pmax <= THRL), 1)) {
        const float d = fmaxf(pmax, 0.f);
        alpha = __builtin_amdgcn_exp2f(-d); m_ref += d;
#pragma unroll
        for (int r = 0; r < 16; ++r) { p0[r] -= d; p1[r] -= d; minit[r] = -m_ref; }
    }
#pragma unroll
    for (int r = 0; r < 16; ++r) p0[r] = __builtin_amdgcn_exp2f(p0[r]);
}
__device__ __forceinline__ void partialSM_post(f32x16& p0, f32x16& p1, float pmax, float& m_ref, f32x16& minit, float& alpha) {
    asm volatile("s_nop 1" ::: );
    { auto rr = __builtin_amdgcn_permlane32_swap(__float_as_uint(pmax), __float_as_uint(pmax), false, false);
      pmax = max2_s(__uint_as_float(rr[0]), __uint_as_float(rr[1])); }
    alpha = 1.f;
    if (!__builtin_expect(__all(pmax <= THRL), 1)) {
        const float d = fmaxf(pmax, 0.f);
        alpha = __builtin_amdgcn_exp2f(-d); m_ref += d;
#pragma unroll
        for (int r = 0; r < 16; ++r) { p0[r] -= d; p1[r] -= d; minit[r] = -m_ref; }
    }
#pragma unroll
    for (int r = 0; r < 16; ++r) p0[r] = __builtin_amdgcn_exp2f(p0[r]);
}
__device__ __forceinline__ void finishSM(f32x16& p0, f32x16& p1, float alpha, float& l_reg, bf16x8& pa0, bf16x8& pa1, bf16x8& pa2, bf16x8& pa3) {
#pragma unroll
    for (int r = 0; r < 16; ++r) p1[r] = __builtin_amdgcn_exp2f(p1[r]);
    float ps = 0;
#pragma unroll
    for (int r = 0; r < 16; ++r) ps += p0[r];
#pragma unroll
    for (int r = 0; r < 16; ++r) ps += p1[r];
    { auto rr = __builtin_amdgcn_permlane32_swap(__float_as_uint(ps), __float_as_uint(ps), false, false);
      ps = __uint_as_float(rr[0]) + __uint_as_float(rr[1]); }
    l_reg = l_reg * alpha + ps;
#define PK4(P, B_, OUT) do { unsigned a0 = cvt_pk_bf16(P[B_+0], P[B_+1]), a1 = cvt_pk_bf16(P[B_+2], P[B_+3]);                          \
        unsigned b0 = cvt_pk_bf16(P[B_+4], P[B_+5]), b1 = cvt_pk_bf16(P[B_+6], P[B_+7]);                                             \
        auto r0 = __builtin_amdgcn_permlane32_swap(a0, b0, false, false); auto r1 = __builtin_amdgcn_permlane32_swap(a1, b1, false, false); \
        u32x4 w = {r0[0], r1[0], r0[1], r1[1]}; OUT = *reinterpret_cast<bf16x8*>(&w); } while (0)
    PK4(p0, 0, pa0); PK4(p0, 8, pa1); PK4(p1, 0, pa2); PK4(p1, 8, pa3);
#undef PK4
}
template <int KB>
__device__ __forceinline__ void qkt(f32x16& p0, f32x16& p1, const char* K_lds, int r32, int hi, const bf16x8* qr, const f32x16& minit) {
    const char* kb[4];
#pragma unroll
    for (int dd = 0; dd < 4; ++dd) kb[dd] = K_lds + KB * SHM_K + KSWZ(r32, (dd * 16 + hi * 8) * 2);
#pragma unroll
    for (int d0 = 0; d0 < 8; ++d0) { const char* a = kb[d0 & 3] + (d0 >> 2) * 128;
        bf16x8 b0 = *reinterpret_cast<const bf16x8*>(a);
        bf16x8 b1 = *reinterpret_cast<const bf16x8*>(a + 32 * 256);
        p0 = __builtin_amdgcn_mfma_f32_32x32x16_bf16(b0, qr[d0], d0 == 0 ? minit : p0, 0, 0, 0);
        p1 = __builtin_amdgcn_mfma_f32_32x32x16_bf16(b1, qr[d0], d0 == 0 ? minit : p1, 0, 0, 0); }
}
template <int KB>
__device__ __forceinline__ void qkt_fsm(f32x16& x0, f32x16& x1, const char* K_lds, int r32, int hi, const bf16x8* qr, const f32x16& minit,
                                        f32x16& y0, f32x16& y1, float alpha, float& l_reg, bf16x8& pa0, bf16x8& pa1, bf16x8& pa2, bf16x8& pa3) {
    const char* kb[4];
#pragma unroll
    for (int dd = 0; dd < 4; ++dd) kb[dd] = K_lds + KB * SHM_K + KSWZ(r32, (dd * 16 + hi * 8) * 2);
    bf16x8 b0 = *reinterpret_cast<const bf16x8*>(kb[0]), b1 = *reinterpret_cast<const bf16x8*>(kb[0] + 32 * 256), n0 = b0, n1 = b1;
    float ps = 0.f; unsigned c[16]; u32x4 w0, w1, w2, w3;
#define FS_GAP(g) do { y1[g] = __builtin_amdgcn_exp2f(y1[g]); ps += y0[g]; if ((g) >= 1) ps += y1[(g) - 1];                                         \
        if ((g) < 8) c[g] = cvt_pk_bf16(y0[2 * (g)], y0[2 * (g) + 1]); else if ((g) < 15) c[g] = cvt_pk_bf16(y1[2 * ((g) - 8)], y1[2 * ((g) - 8) + 1]);   \
        if ((g) == 4)  { auto r_ = __builtin_amdgcn_permlane32_swap(c[0], c[2], false, false); w0[0] = r_[0]; w0[2] = r_[1]; }                                  \
        if ((g) == 5)  { auto r_ = __builtin_amdgcn_permlane32_swap(c[1], c[3], false, false); w0[1] = r_[0]; w0[3] = r_[1]; }                                  \
        if ((g) == 8)  { auto r_ = __builtin_amdgcn_permlane32_swap(c[4], c[6], false, false); w1[0] = r_[0]; w1[2] = r_[1]; }                                  \
        if ((g) == 9)  { auto r_ = __builtin_amdgcn_permlane32_swap(c[5], c[7], false, false); w1[1] = r_[0]; w1[3] = r_[1]; }                                  \
        if ((g) == 12) { auto r_ = __builtin_amdgcn_permlane32_swap(c[8], c[10], false, false); w2[0] = r_[0]; w2[2] = r_[1]; }                                 \
        if ((g) == 13) { auto r_ = __builtin_amdgcn_permlane32_swap(c[9], c[11], false, false); w2[1] = r_[0]; w2[3] = r_[1]; }                                 \
        __builtin_amdgcn_sched_barrier(0); } while (0)
#pragma unroll
    for (int d0 = 0; d0 < 8; ++d0) {
        if (d0 < 7) { const char* a = kb[(d0 + 1) & 3] + ((d0 + 1) >> 2) * 128; n0 = *reinterpret_cast<const bf16x8*>(a); n1 = *reinterpret_cast<const bf16x8*>(a + 32 * 256); }
        x0 = __builtin_amdgcn_mfma_f32_32x32x16_bf16(b0, qr[d0], d0 == 0 ? minit : x0, 0, 0, 0);
        FS_GAP(2 * d0);
        x1 = __builtin_amdgcn_mfma_f32_32x32x16_bf16(b1, qr[d0], d0 == 0 ? minit : x1, 0, 0, 0);
        FS_GAP(2 * d0 + 1);
        b0 = n0; b1 = n1;
    }
#undef FS_GAP
    ps += y1[15]; c[15] = cvt_pk_bf16(y1[14], y1[15]);
    { auto r_ = __builtin_amdgcn_permlane32_swap(c[12], c[14], false, false); w3[0] = r_[0]; w3[2] = r_[1]; }
    { auto r_ = __builtin_amdgcn_permlane32_swap(c[13], c[15], false, false); w3[1] = r_[0]; w3[3] = r_[1]; }
    { auto rr = __builtin_amdgcn_permlane32_swap(__float_as_uint(ps), __float_as_uint(ps), false, false);
      ps = __uint_as_float(rr[0]) + __uint_as_float(rr[1]); }
    l_reg = l_reg * alpha + ps;
    pa0 = *reinterpret_cast<bf16x8*>(&w0); pa1 = *reinterpret_cast<bf16x8*>(&w1); pa2 = *reinterpret_cast<bf16x8*>(&w2); pa3 = *reinterpret_cast<bf16x8*>(&w3);
}
template <int VB>
__device__ __forceinline__ void pv_tile(f32x16* o, int vb0, bf16x8 pa0, bf16x8 pa1, bf16x8 pa2, bf16x8 pa3) {
#define TRRD(dst, off) asm volatile("ds_read_b64_tr_b16 %0, %1 offset:%2" : "=&v"(dst) : "v"(vb0), "i"(off) : "memory")
#define PV_D0(d0) do { s16x4 l0, l1, l2, l3, h0, h1, h2, h3; constexpr int b_ = VB * SHM_V + v_rd_off(d0, 0, 0); \
        TRRD(l0, b_); TRRD(h0, b_ + 2048); TRRD(l1, b_ + 4096); TRRD(h1, b_ + 6144); TRRD(l2, b_ + 8192); TRRD(h2, b_ + 10240); TRRD(l3, b_ + 12288); TRRD(h3, b_ + 14336); \
        asm volatile("s_waitcnt lgkmcnt(0)" ::: "memory"); SBAR();   \
        o[d0] = __builtin_amdgcn_mfma_f32_32x32x16_bf16(pa0, (bf16x8){l0[0], l0[1], l0[2], l0[3], h0[0], h0[1], h0[2], h0[3]}, o[d0], 0, 0, 0);   \
        o[d0] = __builtin_amdgcn_mfma_f32_32x32x16_bf16(pa1, (bf16x8){l1[0], l1[1], l1[2], l1[3], h1[0], h1[1], h1[2], h1[3]}, o[d0], 0, 0, 0);   \
        o[d0] = __builtin_amdgcn_mfma_f32_32x32x16_bf16(pa2, (bf16x8){l2[0], l2[1], l2[2], l2[3], h2[0], h2[1], h2[2], h2[3]}, o[d0], 0, 0, 0);   \
        o[d0] = __builtin_amdgcn_mfma_f32_32x32x16_bf16(pa3, (bf16x8){l3[0], l3[1], l3[2], l3[3], h3[0], h3[1], h3[2], h3[3]}, o[d0], 0, 0, 0); } while (0)
    PV_D0(0); PV_D0(1); PV_D0(2); PV_D0(3);
#undef PV_D0
#undef TRRD
}

template <int VB>
__device__ __forceinline__ float pv_tile_sm(f32x16* o, int vb0, bf16x8 pa0, bf16x8 pa1, bf16x8 pa2, bf16x8 pa3, f32x16& x0, f32x16& x1, unsigned long long mw, int hi) {
    const unsigned long long sh = mw >> (4 * hi);
    const int lo = (int)(unsigned)sh, hh = (int)(unsigned)(sh >> 32);
    const int NEG = (int)0xff800000u;
    float pmax = __int_as_float(NEG);
#define TRRD(dst, off) asm volatile("ds_read_b64_tr_b16 %0, %1 offset:%2" : "=&v"(dst) : "v"(vb0), "i"(off) : "memory")
#define PV_LD(S_, d0) do { constexpr int b_ = VB * SHM_V + v_rd_off(d0, 0, 0); \
        TRRD(S_##l0, b_); TRRD(S_##h0, b_ + 2048); TRRD(S_##l1, b_ + 4096); TRRD(S_##h1, b_ + 6144); TRRD(S_##l2, b_ + 8192); TRRD(S_##h2, b_ + 10240); TRRD(S_##l3, b_ + 12288); TRRD(S_##h3, b_ + 14336); } while (0)
#define PV_WAIT() do { asm volatile("s_waitcnt lgkmcnt(0)" ::: "memory"); SBAR(); } while (0)
#define PV_MMA(S_, d0) do { \
        o[d0] = __builtin_amdgcn_mfma_f32_32x32x16_bf16(pa0, (bf16x8){S_##l0[0], S_##l0[1], S_##l0[2], S_##l0[3], S_##h0[0], S_##h0[1], S_##h0[2], S_##h0[3]}, o[d0], 0, 0, 0);   \
        o[d0] = __builtin_amdgcn_mfma_f32_32x32x16_bf16(pa1, (bf16x8){S_##l1[0], S_##l1[1], S_##l1[2], S_##l1[3], S_##h1[0], S_##h1[1], S_##h1[2], S_##h1[3]}, o[d0], 0, 0, 0);   \
        o[d0] = __builtin_amdgcn_mfma_f32_32x32x16_bf16(pa2, (bf16x8){S_##l2[0], S_##l2[1], S_##l2[2], S_##l2[3], S_##h2[0], S_##h2[1], S_##h2[2], S_##h2[3]}, o[d0], 0, 0, 0);   \
        o[d0] = __builtin_amdgcn_mfma_f32_32x32x16_bf16(pa3, (bf16x8){S_##l3[0], S_##l3[1], S_##l3[2], S_##l3[3], S_##h3[0], S_##h3[1], S_##h3[2], S_##h3[3]}, o[d0], 0, 0, 0); } while (0)
#define SM_SLICE(d0) do { _Pragma("unroll") for (int r = 4 * (d0); r < 4 * (d0) + 4; ++r) { const int c = (r & 3) + 8 * (r >> 2);          \
        const int m0 = __builtin_amdgcn_sbfe(lo, c, 1), m1 = __builtin_amdgcn_sbfe(hh, c, 1); float q0 = x0[r], q1 = x1[r];                        \
        asm("v_bfi_b32 %0, %1, %0, %2" : "+v"(q0) : "v"(m0), "s"(NEG)); asm("v_bfi_b32 %0, %1, %0, %2" : "+v"(q1) : "v"(m1), "s"(NEG));             \
        x0[r] = q0; x1[r] = q1; pmax = max3_s(pmax, q0, q1); } } while (0)
    s16x4 Al0, Al1, Al2, Al3, Ah0, Ah1, Ah2, Ah3, Bl0, Bl1, Bl2, Bl3, Bh0, Bh1, Bh2, Bh3;
    PV_LD(A, 0); PV_WAIT();
    PV_MMA(A, 0); PV_LD(B, 1); SM_SLICE(0); PV_WAIT();
    PV_MMA(B, 1); PV_LD(A, 2); SM_SLICE(1); PV_WAIT();
    PV_MMA(A, 2); PV_LD(B, 3); SM_SLICE(2); PV_WAIT();
    PV_MMA(B, 3); SM_SLICE(3);
#undef SM_SLICE
#undef PV_MMA
#undef PV_WAIT
#undef PV_LD
#undef TRRD
    return pmax;
}

struct Blk { const bf16_t* Q; const bf16_t* K; const bf16_t* V; const bf16_t* Gt; bf16_t* Y; const unsigned long long* M; int P0; int NT; };
struct Seam { bf16x8 qr[8]; bf16x8 st_v0, st_v1, st_k0, st_k1; };
#define ROW(p, k0, rr) ((p) + (size_t)((k0) + (rr)) * RS + sc)
#define VMW() asm volatile("s_waitcnt vmcnt(0)" ::: "memory")
#define VMWN(n) asm volatile("s_waitcnt vmcnt(%0)" :: "i"(n) : "memory")
#define SLOAD_H(Kp, Vp, k0) do { const char* kt_ = (const char*)(Kp) + (size_t)(k0) * (RS * 2); const char* vt_ = (const char*)(Vp) + (size_t)(k0) * (RS * 2);   \
                         S.st_v0 = *(const bf16x8*)(vt_ + ldo0); S.st_v1 = *(const bf16x8*)(vt_ + 32 * RS * 2 + ldo0);              \
                         S.st_k0 = *(const bf16x8*)(kt_ + ldo0); S.st_k1 = *(const bf16x8*)(kt_ + 32 * RS * 2 + ldo0); } while (0)
#define SWRITE_HK(bf) do { *(bf16x8*)(K_lds + (bf) * SHM_K + kws) = S.st_k0; *(bf16x8*)(K_lds + (bf) * SHM_K + kws + 32 * 256) = S.st_k1; } while (0)
#define SWRITE_HV(bf) do { *(bf16x8*)(V_lds + (bf) * SHM_V + vst0) = S.st_v0; *(bf16x8*)(V_lds + (bf) * SHM_V + vst0 + 8192) = S.st_v1; } while (0)
#define SWRITE_H(bf) do { SWRITE_HV(bf); SWRITE_HK(bf); } while (0)
__device__ __forceinline__ void prime(const Blk& cur, char* lds, Seam& S, int tid) {
    const int wid = __builtin_amdgcn_readfirstlane(tid >> 6), lane = tid & 63, r32 = lane & 31, hi = lane >> 5;
    const int sr = tid >> 4, sc = (tid & 15) * 8, kws = KSWZ(sr, sc * 2); char* K_lds = lds + 2 * SHM_V;
    const unsigned ldo0 = (unsigned)(sr * RS + sc) * 2u;
    const int kb0 = 3 * KVBLK;
#pragma unroll
    for (int d0 = 0; d0 < 8; ++d0) S.qr[d0] = load8(cur.Q + (size_t)(cur.P0 + wid * QBLK + r32) * RS + d0 * 16 + hi * 8);
    SLOAD_H(cur.K, cur.V, kb0); VMW(); SWRITE_HK(0);
    __syncthreads();
}
__device__ __forceinline__ void block(const Blk& cur, const Blk& nxt, const float* lutg, char* lds, Seam& S, int tid, const bool dry) {
    const int wid = __builtin_amdgcn_readfirstlane(tid >> 6), lane = tid & 63, r32 = lane & 31, hi = lane >> 5;
    const int NT = cur.NT;
    const int kbn = 3 * KVBLK;
    const int qlo = cur.P0 + wid * QBLK, qm = qlo + r32 - 4 * hi;
    char* V_lds = lds; char* K_lds = lds + 2 * SHM_V;
    float* ws = (float*)(lds + WS_OFF) + wid * 64; float* li_l = ws, * al_l = ws + 32;
    float* lut = (float*)(lds + LUT_OFF);
    { int tl = tid; asm volatile("" : "+v"(tl)); if (tl < 128) lut[tl] = lutg[tl]; }
    float m_reg = 0.f, l_reg = 0; f32x16 o[4] = {}; f32x16 minit = {};
    const int sr = tid >> 4, sc = (tid & 15) * 8, vst0 = v_st(sr, sc), kws = KSWZ(sr, sc * 2);
    const unsigned ldo0 = (unsigned)(sr * RS + sc) * 2u;
    const int vb0 = (int)(uintptr_t)V_lds + v_rd_base(lane);
    const bf16_t* Kh = cur.K; const bf16_t* Vh = cur.V;
    const unsigned moff = (unsigned)(wid * QBLK + r32) * 8u;
#define RESC(a) do { if (__any((a) < 1.f)) { if (hi == 0) al_l[r32] = (a); asm volatile("s_waitcnt lgkmcnt(0)" ::: "memory");              \
                     for (int d_ = 0; d_ < 4; ++d_) for (int r = 0; r < 16; ++r) o[d_][r] *= al_l[crow(r, hi)]; } } while (0)
#define KBASE(t) ((3 + (t)) * KVBLK)
#define MLOAD(t) (*(const unsigned long long*)((const char*)cur.M + (size_t)(3 + (t)) * 2048 + moff))
#define MASKT(P0_, P1_, mw_, t) do { const int kb_ = KBASE(t); if (kb_ + KVBLK - 1 + 113 > qlo) bias_tile(P0_, P1_, qm - kb_, lut); mask_tile(P0_, P1_, mw_, hi); } while (0)
    constexpr int NQL = 8;
#define SEAM_K0() do { VMWN(NQL); SWRITE_HK(0); SBAR(); } while (0)
    f32x16 pA0, pA1, pB0, pB1; float alA, alB; bf16x8 pa0, pa1, pa2, pa3; unsigned long long mwA, mwB;
    SWRITE_HV(0); SBAR();
    mwA = MLOAD(0);
    if (NT > 1) SLOAD_H(Kh, Vh, KBASE(1));
    SBAR(); qkt<0>(pA0, pA1, K_lds, r32, hi, S.qr, minit);
    __syncthreads();
    asm volatile("s_nop 15\n\ts_nop 3" ::: "memory");
    MASKT(pA0, pA1, mwA, 0); partialSM(pA0, pA1, m_reg, minit, alA);
    if (NT > 1) { VMW(); SWRITE_HK(1); }
    __syncthreads();
#define HALF_STEP(PX0, PX1, mnX, alX, mwX, PY0, PY1, alY, t, KB, VB, SB) do {                                                      \
        SWRITE_HV(KB); SBAR(); mwX = MLOAD(t); if ((t) + 1 < NT) { SLOAD_H(Kh, Vh, KBASE((t) + 1)); SBAR(); }       \
        qkt_fsm<KB>(PX0, PX1, K_lds, r32, hi, S.qr, minit, PY0, PY1, alY, l_reg, pa0, pa1, pa2, pa3); SBAR();      \
        if ((t) + 1 < NT) { VMW(); SWRITE_HK(SB); SBAR(); }          \
        { const int kb_ = KBASE(t); if (kb_ + KVBLK - 1 + 113 > qlo) { int lt_ = r32 | (hi << 5); asm volatile("" : "+v"(lt_)); bias_tile(PX0, PX1, qlo + (lt_ & 31) - 4 * (lt_ >> 5) - kb_, lut); } }   \
        { const float pm_ = pv_tile_sm<VB>(o, vb0, pa0, pa1, pa2, pa3, PX0, PX1, mwX, hi);                                                                          \
          partialSM_post(PX0, PX1, pm_, m_reg, minit, alX); }                                                                                                              \
        RESC(alX); __syncthreads(); } while (0)
    for (int t = 1; t + 1 < NT; t += 2) {
        HALF_STEP(pB0, pB1, mnB, alB, mwB, pA0, pA1, alA, t, 1, 0, 0);
        HALF_STEP(pA0, pA1, mnA, alA, mwA, pB0, pB1, alB, t + 1, 0, 1, 1);
    }
    const bool even = (NT & 1) == 0;
    if (even) { SWRITE_HV(1); SBAR(); mwB = MLOAD(NT - 1); qkt<1>(pB0, pB1, K_lds, r32, hi, S.qr, minit); SBAR(); }
    SLOAD_H(nxt.K, nxt.V, kbn); SBAR();
    unsigned qlo_; { int lt = r32 | (hi << 5); asm volatile("" : "+v"(lt)); qlo_ = (unsigned)((lt & 31) * RS + (lt >> 5) * 8) * 2u; }
#pragma unroll
    for (int d0 = 0; d0 < 8; ++d0) S.qr[d0] = *(const bf16x8*)((const char*)(nxt.Q + (size_t)(nxt.P0 + wid * QBLK) * RS) + qlo_ + d0 * 32);
    SBAR();
    finishSM(pA0, pA1, alA, l_reg, pa0, pa1, pa2, pa3); SBAR();
    pv_tile<0>(o, vb0, pa0, pa1, pa2, pa3);
    if (even) { MASKT(pB0, pB1, mwB, NT - 1); partialSM(pB0, pB1, m_reg, minit, alB); __syncthreads(); RESC(alB);
        finishSM(pB0, pB1, alB, l_reg, pa0, pa1, pa2, pa3); SBAR(); pv_tile<1>(o, vb0, pa0, pa1, pa2, pa3); }
    SBAR(); SEAM_K0();
    if (hi == 0) li_l[r32] = l_reg; asm volatile("s_waitcnt lgkmcnt(0)" ::: "memory");
    { int ln = r32 | (hi << 5); asm volatile("" : "+v"(ln));
      char* et = lds + EPI_OFF + (qlo & 255) * 256;
      char* eb = et + (ln >> 5) * 1024 + (ln & 31) * 2; const float* lb = li_l + (ln >> 5) * 4;
      u32x4 gw[4], yw[4], gx[4], yx[4];
#pragma unroll
      for (int i4 = 0; i4 < 4; ++i4) { const int idx = i4 * 64 + ln; const size_t off = (size_t)(qlo + (idx >> 4)) * RS + (idx & 15) * 8;
          gw[i4] = *(const u32x4*)(cur.Gt + off); yw[i4] = *(const u32x4*)(cur.Y + off); }
#pragma unroll
      for (int r = 0; r < 16; ++r) { const int cr = (r & 3) + 8 * (r >> 2); const float rli = __builtin_amdgcn_rcpf(lb[cr]);
#pragma unroll
          for (int d0 = 0; d0 < 4; ++d0) *(unsigned short*)(eb + cr * 256 + d0 * 64) = (unsigned short)cvt_pk_bf16(o[d0][r] * rli, 0.f); }
      asm volatile("s_waitcnt lgkmcnt(0)" ::: "memory");
#pragma unroll
      for (int i4 = 0; i4 < 4; ++i4) { const int idx = (4 + i4) * 64 + ln; const size_t off = (size_t)(qlo + (idx >> 4)) * RS + (idx & 15) * 8;
          gx[i4] = *(const u32x4*)(cur.Gt + off); yx[i4] = *(const u32x4*)(cur.Y + off); }
#pragma unroll
      for (int i8 = 0; i8 < 8; ++i8) { const int idx = i8 * 64 + ln, row = idx >> 4, ch = idx & 15; const int a = qlo + row;
          const u32x4 ov = *(const u32x4*)(et + row * 256 + ch * 16); const u32x4 g_ = i8 < 4 ? gw[i8 & 3] : gx[i8 & 3], y_ = i8 < 4 ? yw[i8 & 3] : yx[i8 & 3]; u32x4 res;
#pragma unroll
          for (int j = 0; j < 4; ++j) res[j] = cvt_pk_bf16(bf_lo(y_[j]) + sigm_fast(bf_lo(g_[j])) * bf_lo(ov[j]), bf_hi(y_[j]) + sigm_fast(bf_hi(g_[j])) * bf_hi(ov[j]));
          if (a >= PADF && !dry) *(u32x4*)(cur.Y + (size_t)a * RS + ch * 8) = res; } }
    __syncthreads();
#undef RESC
#undef KBASE
#undef MLOAD
#undef MASKT
#undef SEAM_K0
#undef HALF_STEP
}
#undef ROW
#undef VMW
#undef VMWN
#undef SLOAD_H
#undef SWRITE_HK
#undef SWRITE_HV
#undef SWRITE_H
#undef KSWZ
#undef SBAR
}
__device__ __forceinline__ att::Blk attn_blk(int i, const bf16_t* Q, const bf16_t* K, const bf16_t* V, const bf16_t* Gt, bf16_t* Y, const unsigned long long* MASK) {
    const int qblk = 64 - (i >> 4), bh = i & 15, b = bh >> 3, h = bh & 7; const size_t base = (size_t)b * RA * D + h * HD;
    att::Blk r; r.Q = Q + base; r.K = K + base; r.V = V + base; r.Gt = Gt + base; r.Y = Y + base; r.M = mask_chunk(const_cast<unsigned long long*>(MASK), b, qblk, 0); r.P0 = 256 * qblk; r.NT = 4 * qblk + 1;
    return r;
}
__device__ __forceinline__ void phase_attention(LAS unsigned char* lds_, const bf16_t* Q, const bf16_t* K, const bf16_t* V, const bf16_t* Gt, bf16_t* Y, const unsigned long long* MASK, const float* LUT, unsigned* ctr, const bool dry, const int wid0) {
    const int tid = opaque_tid(wid0);
    char* lds = (char*)lds_;
    constexpr int NITEM = 16 * 65;
    volatile LAS unsigned* slot = (volatile LAS unsigned*)(lds_ + MISC_OFF) + 17;
    int i = queue_pop(ctr, slot, tid);
    if (i >= NITEM) return;
    att::Blk cur = attn_blk(i, Q, K, V, Gt, Y, MASK);
    att::Seam S;
    if (__builtin_amdgcn_readfirstlane(tid) >= 256) __builtin_amdgcn_s_setprio(1);
    att::prime(cur, lds, S, tid);
    for (;;) {
        const int in = queue_pop(ctr, slot, tid);
        const bool last = in >= NITEM;
        const att::Blk nxt = last ? cur : attn_blk(in, Q, K, V, Gt, Y, MASK);
        att::block(cur, nxt, LUT + (i & 7) * 128, lds, S, tid, dry);
        if (last) break;
        cur = nxt; i = in;
    }
    __builtin_amdgcn_s_setprio(0);
}

#ifndef N_LAUNCH_MODE
#define N_LAUNCH_MODE 1
#endif
constexpr int NPH_LAYER = 14;
constexpr int PH_FINAL = 1 + DEPTH * NPH_LAYER;
#ifndef ENABLE_ATTN
#define ENABLE_ATTN 1
#endif

#ifndef PMASK
#define PMASK 0xFFFFFFFFu
#endif
#define RUN(p) ((((PMASK) >> ((p) == 0 ? 30 : (p) == PH_FINAL ? 31 : ((p) - 1) % NPH_LAYER)) & 1u) && lo <= (p) && (p) < hi)
#ifndef PROBE_BARX
#define PROBE_BARX 0
#endif
#define GRIDBAR() do { GAS unsigned char* wsbg_ = (GAS unsigned char*)A.ws; asm volatile("" : "+s"(wsbg_)); unsigned char* wsb_ = (unsigned char*)wsbg_; XcdBarrier b_; b_.bar = (unsigned*)(wsb_ + WS_CTL) + 4096; b_.x = xb_xcc_id(); b_.st = (volatile LAS unsigned*)(lds + MISC_OFF) + 8; xcd_barrier(b_, opaque_tid(wid0)); } while (0)
#define SEAM(p) do { if (RUN((p) + 1)) { GRIDBAR(); for (int _b = 0; _b < PROBE_BARX; ++_b) GRIDBAR(); } } while (0)
#ifndef PROBE_DUP
#define PROBE_DUP 0u
#endif
#ifndef PROBE_DUPBAR
#define PROBE_DUPBAR 0
#endif
#define DUPRUN(k, ...) do { if constexpr (((PROBE_DUP) >> (k)) & 1u) { __VA_ARGS__ if (PROBE_DUPBAR) GRIDBAR(); } } while (0)
#define PHASE_BEGIN() GAS unsigned char* wsg_ = (GAS unsigned char*)A.ws; asm volatile("" : "+s"(wsg_)); unsigned char* ws = (unsigned char*)wsg_; const int G = gridDim.x; \
    bf16_t* SA0 = (bf16_t*)(ws + WS_A0); bf16_t* SA1 = (bf16_t*)(ws + WS_A1); bf16_t* SB0 = (bf16_t*)(ws + WS_B0); bf16_t* SB1 = (bf16_t*)(ws + WS_B1); bf16_t* SB2 = (bf16_t*)(ws + WS_B2); bf16_t* SB3 = (bf16_t*)(ws + WS_B3); \
    bf16_t* QI = (bf16_t*)(ws + WS_QI); bf16_t* KI = (bf16_t*)(ws + WS_KI); float* WI = (float*)(ws + WS_WI); float* AGG = (float*)(ws + WS_AGG); float* CARRY = (float*)(ws + WS_CARRY); float* hmeta = (float*)(ws + WS_HMETA); \
    (void)G; (void)SA0; (void)SA1; (void)SB0; (void)SB1; (void)SB2; (void)SB3; (void)QI; (void)KI; (void)WI; (void)AGG; (void)CARRY; (void)hmeta;

template <int l>
__device__ __forceinline__ void layer_phases(const Args& A, LAS unsigned char* lds, const int lo, const int hi, const int wid0) {
        constexpr int pb = 1 + l * NPH_LAYER;
        if (RUN(pb + 0)) { PHASE_BEGIN(); DUPRUN(0, { if (l == 0) phase_rmsnorm<0>(A, A.norm1_g, SA0, wid0); else phase_rmsnorm<1>(A, A.norm1_g + l * D, SA0, wid0); }); if (l == 0) phase_rmsnorm<0>(A, A.norm1_g, SA0, wid0, SB1, SB2); else phase_rmsnorm<1>(A, A.norm1_g + l * D, SA0, wid0, SB1, SB2); SEAM(pb + 0); }
        if (RUN(pb + 1)) { PHASE_BEGIN(); const bf16_t* Win = (const bf16_t*)(ws + WS_WIN + (size_t)l * 16 * MiB);
            pg8::Gemm g{SA0, Win, D, D, D}; pg8::StaticOrder S; S.init(NB * SEQ, NA, G, (int)blockIdx.x);
            pg8::EpiProj E{SB0, SB1, SB2, SB2, QI, KI, WI}; DUPRUN(1, { pg8::gemm_phase(lds, g, S, E, wid0); }); pg8::gemm_phase(lds, g, S, E, wid0);
            { MEpiProj ME{SB0, SB1, SB2, SB2, QI, KI, WI}; meta_gemm(lds, SA0, D, Win, D, NA, D, 1, 1, ME, wid0); } SEAM(pb + 1); }
        if (RUN(pb + 2)) { PHASE_BEGIN(); DUPRUN(2, { phase_conv(SB1, SB3, A.conv_w + l * 4 * D, A.conv_b + l * D, G, wid0); }); phase_conv(SB1, SB3, A.conv_w + l * 4 * D, A.conv_b + l * D, G, wid0); SEAM(pb + 2); }
        if (RUN(pb + 3)) { PHASE_BEGIN(); const bf16_t* Wrg = (const bf16_t*)(ws + WS_WRG + (size_t)l * MiB);
            pg8::Gemm g{SB3, Wrg, D, 256, 256}; pg8::GroupOrder S; S.init(NB * SEQ, 2048, G, (int)blockIdx.x);
            pg8::EpiRGPre E{SA1, SB1}; DUPRUN(3, { pg8::gemm_phase(lds, g, S, E, wid0); }); pg8::gemm_phase(lds, g, S, E, wid0);
            { MEpiRG ME{SA1, SB1}; meta_gemm(lds, SB3, D, Wrg, 256, 2048, 256, 1, 4, ME, wid0); } SEAM(pb + 3); }
        if (RUN(pb + 4)) { PHASE_BEGIN(); DUPRUN(4, { phase_scan_local(SA1, SB1, SB3, A.b_rg_a + l * D, A.b_rg_x + l * D, A.lru_lambda + l * D, AGG, G, A.ph_hi > 0, wid0); }); phase_scan_local(SA1, SB1, SB3, A.b_rg_a + l * D, A.b_rg_x + l * D, A.lru_lambda + l * D, AGG, G, false, wid0); SEAM(pb + 4); }
        if (RUN(pb + 5)) { PHASE_BEGIN(); DUPRUN(5, { phase_scan_carry(AGG, CARRY, wid0); }); phase_scan_carry(AGG, CARRY, wid0); SEAM(pb + 5); }
        if (RUN(pb + 6)) { PHASE_BEGIN(); DUPRUN(6, { phase_scan_apply((const _Float16*)SA1, (const _Float16*)SB1, CARRY, SB0, SB2, SB3, G, wid0); }); phase_scan_apply((const _Float16*)SA1, (const _Float16*)SB1, CARRY, SB0, SB2, SB3, G, wid0); SEAM(pb + 6); }
        if (RUN(pb + 7)) {
#if ENABLE_ATTN
            PHASE_BEGIN(); const bf16_t* Win = (const bf16_t*)(ws + WS_WIN + (size_t)l * 16 * MiB);
            pg8::Gemm g{SA0, Win + (size_t)NA * D, D, D, D}; pg8::StaticOrder S; S.init(NB * SEQ, NBP, G, (int)blockIdx.x);
            pg8::EpiProj E{SB0, SB1, SB2, SA1, QI, KI, WI}; DUPRUN(7, { pg8::gemm_phase(lds, g, S, E, wid0); }); pg8::gemm_phase(lds, g, S, E, wid0);
            { MEpiProj ME{SB0, SB1, SB2, SA1, QI, KI, WI}; meta_gemm(lds, SA0, D, Win + (size_t)NA * D, D, NBP, D, 1, 1, ME, wid0); }
#endif
            SEAM(pb + 7); }
        if (RUN(pb + 8)) {
#if ENABLE_ATTN
            PHASE_BEGIN(); unsigned* qc = (unsigned*)(ws + WS_CTL) + 8192 + (l * 4) * 64; DUPRUN(8, { phase_indexer(lds, QI, KI, WI, (unsigned long long*)SA0, qc + 64, wid0); __syncthreads(); }); phase_indexer(lds, QI, KI, WI, (unsigned long long*)SA0, qc, wid0);
#endif
            SEAM(pb + 8); }
        if (RUN(pb + 9)) {
#if ENABLE_ATTN
            PHASE_BEGIN(); unsigned* qc = (unsigned*)(ws + WS_CTL) + 8192 + (l * 4 + 2) * 64; DUPRUN(9, { phase_attention(lds, SB0, SB1, SB2, SA1, SB3, (const unsigned long long*)SA0, (const float*)(ws + WS_LUT), qc + 64, A.ph_hi > 0, wid0); __syncthreads(); }); phase_attention(lds, SB0, SB1, SB2, SA1, SB3, (const unsigned long long*)SA0, (const float*)(ws + WS_LUT), qc, false, wid0);
#endif
            SEAM(pb + 9); }
        if (RUN(pb + 10)) { PHASE_BEGIN(); const bf16_t* Wout = (const bf16_t*)(ws + WS_WOUT + (size_t)l * 2 * MiB);
            pg8::Gemm g{SB3, Wout, D, D, D}; pg8::StaticOrder S; S.init(NB * SEQ, D, G, (int)blockIdx.x);
            pg8::EpiRes E{A.out, hmeta, 0, l == 0 ? (long)(A.x - A.out) : 0l}; DUPRUN(10, { pg8::EpiRes Ed{A.out, hmeta, A.ph_hi > 0, 0l}; pg8::gemm_phase(lds, g, S, Ed, wid0); }); pg8::gemm_phase(lds, g, S, E, wid0);
            if (l + 1 < DEPTH) { MEpiRes ME{A.out, hmeta}; meta_gemm(lds, SB3, D, Wout, D, D, D, 4, 1, ME, wid0); } SEAM(pb + 10); }
        if (RUN(pb + 11)) { PHASE_BEGIN(); DUPRUN(11, { phase_rmsnorm<1>(A, A.norm2_g + l * D, SA0, wid0); }); phase_rmsnorm<1>(A, A.norm2_g + l * D, SA0, wid0); SEAM(pb + 11); }
        if (RUN(pb + 12)) { PHASE_BEGIN(); const bf16_t* W1 = (const bf16_t*)(ws + WS_W1 + (size_t)l * 8 * MiB);
            pg8::Gemm g{SA0, W1, D, D, D}; pg8::StaticOrder S; S.init(NB * SEQ, FF, G, (int)blockIdx.x);
            pg8::EpiRelu2 E{SB0, FF}; DUPRUN(12, { pg8::gemm_phase(lds, g, S, E, wid0); }); pg8::gemm_phase(lds, g, S, E, wid0);
            if (l + 1 < DEPTH) { MEpiRelu2 ME{SB0}; meta_gemm(lds, SA0, D, W1, D, FF, D, 1, 1, ME, wid0); } SEAM(pb + 12); }
        if (RUN(pb + 13)) { PHASE_BEGIN(); const bf16_t* W2 = (const bf16_t*)(ws + WS_W2 + (size_t)l * 8 * MiB);
            pg8::Gemm g{SB0, W2, FF, FF, FF}; pg8::StaticOrder S; S.init(NB * SEQ, D, G, (int)blockIdx.x);
            pg8::EpiRes E{A.out, hmeta, 0, 0l}; DUPRUN(13, { pg8::EpiRes Ed{A.out, hmeta, A.ph_hi > 0, 0l}; pg8::gemm_phase(lds, g, S, Ed, wid0); }); pg8::gemm_phase(lds, g, S, E, wid0);
            if (l + 1 < DEPTH) { MEpiRes ME{A.out, hmeta}; meta_gemm(lds, SB0, FF, W2, FF, D, FF, 4, 1, ME, wid0); } SEAM(pb + 13); }
}

__global__ void __launch_bounds__(NTHREADS, 2) mega_fwd(Args A_) {
    Args A = A_;
    A.x = as_global(A.x); A.norm1_g = as_global(A.norm1_g); A.w_in = as_global(A.w_in); A.conv_w = as_global(A.conv_w); A.conv_b = as_global(A.conv_b); A.w_rg_a = as_global(A.w_rg_a); A.b_rg_a = as_global(A.b_rg_a);
    A.w_rg_x = as_global(A.w_rg_x); A.b_rg_x = as_global(A.b_rg_x); A.lru_lambda = as_global(A.lru_lambda); A.w_out = as_global(A.w_out); A.norm2_g = as_global(A.norm2_g); A.w_mlp1 = as_global(A.w_mlp1); A.w_mlp2 = as_global(A.w_mlp2);
    A.rel_bias = as_global(A.rel_bias); A.meta = as_global(A.meta); A.final_g = as_global(A.final_g); A.out = as_global(A.out); A.ws = as_global(A.ws);
    extern __shared__ __attribute__((aligned(16))) unsigned char lds_raw[];
    LAS unsigned char* lds = (LAS unsigned char*)lds_raw;
    volatile LAS unsigned* MISC = (volatile LAS unsigned*)(lds + MISC_OFF);
    const int wid0 = __builtin_amdgcn_readfirstlane(threadIdx.x >> 6);
    if (threadIdx.x < 64) MISC[threadIdx.x] = 0u;
    __syncthreads();
    (void)xcd_barrier_post((unsigned*)(A.ws + WS_CTL) + 4096, MISC + 8);
    const int lo = A.ph_lo, hi = A.ph_hi;
    if (RUN(0)) { DUPRUN(14, { phase_prologue(A, lds, wid0); __syncthreads(); }); phase_prologue(A, lds, wid0); __syncthreads(); if (N_LAUNCH_MODE == 0) SEAM(0); }
    layer_phases<0>(A, lds, lo, hi, wid0);
    layer_phases<1>(A, lds, lo, hi, wid0);
    if (RUN(PH_FINAL)) phase_rmsnorm<2>(A, A.final_g, nullptr, wid0);
}
#undef RUN
#undef SEAM

extern "C" void kernel_launch(void* const* d_in, const int* in_sizes, int n_in, void* d_out, int out_size, void* d_ws, size_t ws_size, hipStream_t stream) {
    static int grid = 0;
    if (grid == 0) {
        if (n_in != 17 || out_size != NB * SEQ * D || ws_size < WS_END) { fprintf(stderr, "kernel_launch: unexpected shapes (n_in %d out %d ws %zu)\n", n_in, out_size, ws_size); grid = -1; return; }
        int dev = 0, cus = 0, per_cu = 0;
        if (hipGetDevice(&dev) != hipSuccess || hipDeviceGetAttribute(&cus, hipDeviceAttributeMultiprocessorCount, dev) != hipSuccess) { grid = -1; return; }
        if (hipFuncSetAttribute((const void*)mega_fwd, hipFuncAttributeMaxDynamicSharedMemorySize, LDS_BYTES) != hipSuccess) { fprintf(stderr, "kernel_launch: hipFuncSetAttribute failed\n"); grid = -1; return; }
        if (hipOccupancyMaxActiveBlocksPerMultiprocessor(&per_cu, (const void*)mega_fwd, NTHREADS, LDS_BYTES) != hipSuccess || per_cu < 1) { fprintf(stderr, "kernel_launch: occupancy query says %d\n", per_cu); }
        (void)hipGetLastError();
        grid = cus;
    }
    if (grid < 0) return;
    (void)hipMemsetAsync((char*)d_ws + WS_CTL, 0, CTL_ZERO_BYTES, stream);
    Args a{};
    a.x = (const float*)d_in[0]; a.norm1_g = (const float*)d_in[1]; a.w_in = (const float*)d_in[2]; a.conv_w = (const float*)d_in[3]; a.conv_b = (const float*)d_in[4];
    a.w_rg_a = (const float*)d_in[5]; a.b_rg_a = (const float*)d_in[6]; a.w_rg_x = (const float*)d_in[7]; a.b_rg_x = (const float*)d_in[8]; a.lru_lambda = (const float*)d_in[9];
    a.w_out = (const float*)d_in[10]; a.norm2_g = (const float*)d_in[11]; a.w_mlp1 = (const float*)d_in[12]; a.w_mlp2 = (const float*)d_in[13]; a.rel_bias = (const float*)d_in[14];
    a.meta = (const float*)d_in[15]; a.final_g = (const float*)d_in[16]; a.out = (float*)d_out; a.ws = (unsigned char*)d_ws;
#if N_LAUNCH_MODE == 1
    a.ph_lo = 0; a.ph_hi = PH_FINAL + 1;
    hipLaunchKernelGGL(mega_fwd, dim3(grid), dim3(NTHREADS), LDS_BYTES, stream, a);
#else
    for (int p = 0; p <= PH_FINAL; ++p) { a.ph_lo = p; a.ph_hi = p + 1; hipLaunchKernelGGL(mega_fwd, dim3(grid), dim3(NTHREADS), LDS_BYTES, stream, a); }
#endif
}
```

```cpp
#include <hip/hip_runtime.h>
#include <cstdio>
#include <cstdint>

#define LAS __attribute__((address_space(3)))
typedef unsigned short bf16_t;
typedef short bf16x8 __attribute__((ext_vector_type(8)));
typedef short s16x4 __attribute__((ext_vector_type(4)));
typedef float f32x4 __attribute__((ext_vector_type(4)));
typedef float f32x2 __attribute__((ext_vector_type(2)));
typedef float f32x16 __attribute__((ext_vector_type(16)));
typedef unsigned u32x4 __attribute__((ext_vector_type(4)));
typedef unsigned u32x2 __attribute__((ext_vector_type(2)));
typedef _Float16 h16x4 __attribute__((ext_vector_type(4)));
typedef _Float16 h16x2 __attribute__((ext_vector_type(2)));
typedef _Float16 h16x4 __attribute__((ext_vector_type(4)));

constexpr int NB = 2, SEQ = 16384, NMETA = 16, PADF = 240, RA = 16640, R = NB * RA;
constexpr int D = 1024, NH = 8, HD = 128, IH = 8, IDIM = 64, FF = 4096, NIN = 7752, DEPTH = 2;
constexpr float EPS = 1e-6f;
constexpr int NA = 3072, NBP = 4864;
constexpr int WIN_ROWS = NA + NBP;
constexpr int NWAVES = 8, NTHREADS = 512;

constexpr size_t MiB = 1u << 20;
constexpr size_t SLOT = (size_t)R * D * 2;
constexpr size_t WS_CTL = 0, CTL_ZERO_BYTES = 1 * MiB;
constexpr size_t WS_WIN = 1 * MiB;
constexpr size_t WS_WOUT = 33 * MiB;
constexpr size_t WS_W1 = 37 * MiB;
constexpr size_t WS_W2 = 53 * MiB;
constexpr size_t WS_WRG = 69 * MiB;
constexpr size_t WS_HMETA = 71 * MiB;
constexpr size_t WS_WI = 73 * MiB;
constexpr size_t WS_KI = 75 * MiB;
constexpr size_t WS_QI = 80 * MiB;
constexpr size_t WS_AGG = 113 * MiB;
constexpr size_t WS_CARRY = 118 * MiB;
constexpr size_t WS_LUT = 121 * MiB;
constexpr size_t WS_A0 = 122 * MiB, WS_A1 = 187 * MiB, WS_B0 = 252 * MiB, WS_B1 = 317 * MiB, WS_B2 = 382 * MiB, WS_B3 = 447 * MiB, WS_END = 512 * MiB;
static_assert(SLOT == 65 * MiB && WS_B3 + SLOT == WS_END, "ws map");
constexpr int NCHUNK = 256, CHROWS = 65;
constexpr int MASK_CHUNKS_PER_BATCH = 2 * 65 * 66;

constexpr int LDS_BYTES = 147456;
constexpr int MISC_OFF = 131072 + 4096;

#define GAS __attribute__((address_space(1)))
template <class T> __device__ __forceinline__ T* as_global(T* p) { return (T*)(GAS T*)p; }
__device__ __forceinline__ int opaque_tid(int wid0) { int l; asm volatile("v_mbcnt_lo_u32_b32 %0, -1, 0\n\tv_mbcnt_hi_u32_b32 %0, -1, %0" : "=v"(l)); return wid0 * 64 + l; }
__device__ __forceinline__ unsigned cvt_pk_bf16(float lo, float hi) { unsigned r; asm volatile("v_cvt_pk_bf16_f32 %0, %1, %2" : "=v"(r) : "v"(lo), "v"(hi)); return r; }
__device__ __forceinline__ float bf_lo(unsigned w) { return __uint_as_float(w << 16); }
__device__ __forceinline__ float bf_hi(unsigned w) { return __uint_as_float(w & 0xffff0000u); }
__device__ __forceinline__ float wave_sum(float v) {
#pragma unroll
    for (int o = 1; o < 64; o <<= 1) v += __shfl_xor(v, o);
    return v;
}
__device__ __forceinline__ float sigmoidf_(float x) { return 1.0f / (1.0f + __expf(-x)); }
__device__ __forceinline__ float sigm_fast(float x) { return __builtin_amdgcn_rcpf(1.0f + __expf(-x)); }
__device__ __forceinline__ float gelu_tanh(float x) { const float z = 0.7978845608028654f * (x + 0.044715f * x * x * x); const float t = 1.0f - 2.0f / (__expf(2.0f * z) + 1.0f); return 0.5f * x * (1.0f + t); }
__device__ __forceinline__ float* hrow(float* out, float* hmeta, int r) {
    const int b = r >= RA ? 1 : 0, a = r - b * RA;
    return a >= 256 ? out + ((size_t)(b * SEQ + a - 256) << 10) : hmeta + ((size_t)(b * 256 + a) << 10);
}

#define XB_TMO      128
#define XB_XCNT(j)  (256  + 64 * (j))
#define XB_XSUB(j)  (1280 + 64 * (j))
#define XB_XGEN(j)  (2304 + 64 * (j))
#define XB_TOP      3328
#define XB_TOPGEN   3392
#define XCD_BAR_WORDS 3456
#define XB_SPIN_CAP (1u << 22)
__device__ __forceinline__ unsigned xb_ld(unsigned* p)              { return __hip_atomic_load(p, __ATOMIC_RELAXED, __HIP_MEMORY_SCOPE_AGENT); }
__device__ __forceinline__ unsigned xb_add(unsigned* p, unsigned v) { return __hip_atomic_fetch_add(p, v, __ATOMIC_RELAXED, __HIP_MEMORY_SCOPE_AGENT); }
__device__ __forceinline__ unsigned xb_xcc_id() { return (unsigned)__builtin_amdgcn_s_getreg((3 << 11) | 20) & 0xFu; }
#define XB_SPIN(cond, bar) do { unsigned _sp = 0; while (cond) { __builtin_amdgcn_s_sleep(1); \
    if ((++_sp & 255u) == 0u) { if (xb_ld(&(bar)[XB_TMO])) break; if (_sp > XB_SPIN_CAP) { atomicAdd(&(bar)[XB_TMO], 1u); break; } } } } while (0)
struct XcdBarrier { unsigned* bar; unsigned x; volatile LAS unsigned* st; };
__device__ __forceinline__ XcdBarrier xcd_barrier_post(unsigned* bar, volatile LAS unsigned* st) {
    XcdBarrier b; b.bar = bar; b.x = xb_xcc_id(); b.st = st;
    if (threadIdx.x == 0) (void)xb_add(&bar[XB_XCNT(b.x)], 1u);
    return b;
}
__device__ __forceinline__ void xcd_barrier_complete(unsigned* bar, unsigned x, unsigned& nloc, unsigned& nx) {
    const unsigned G = gridDim.x * gridDim.y * gridDim.z;
    unsigned sum, cnt, mine, sp = 0u;
    for (;;) {
        sum = 0u; cnt = 0u; mine = 0u;
#pragma unroll
        for (unsigned j = 0; j < 16; ++j) { const unsigned c = xb_ld(&bar[XB_XCNT(j)]); sum += c; cnt += (c > 0u) ? 1u : 0u; mine = (j == x) ? c : mine; }
        if (sum == G) break;
        __builtin_amdgcn_s_sleep(1);
        if ((++sp & 255u) == 0u) { if (xb_ld(&bar[XB_TMO])) break; if (sp > XB_SPIN_CAP) { atomicAdd(&bar[XB_TMO], 1u); break; } }
    }
    nloc = mine > 0u ? mine : 1u; nx = cnt > 0u ? cnt : 1u;
}
__device__ __forceinline__ void xcd_barrier(const XcdBarrier& b, const int tid) {
    asm volatile("s_waitcnt vmcnt(0)" ::: "memory");
    __syncthreads();
    if (tid == 0) {
        unsigned* bar = b.bar;
        __builtin_amdgcn_s_waitcnt(0);
        unsigned nloc = b.st[0], nx = b.st[1];
        if (nloc == 0u) { xcd_barrier_complete(bar, b.x, nloc, nx); b.st[0] = nloc; b.st[1] = nx; }
        const unsigned old = xb_add(&bar[XB_XSUB(b.x)], 1u);
        const unsigned gen = old / nloc;
        if (old + 1u == (gen + 1u) * nloc) {
            __builtin_amdgcn_fence(__ATOMIC_RELEASE, "agent");
            asm volatile("s_waitcnt vmcnt(0)" ::: "memory");
            const unsigned og = xb_add(&bar[XB_TOP], 1u);
            const unsigned tg = og / nx;
            if (og + 1u == (tg + 1u) * nx) xb_add(&bar[XB_TOPGEN], 1u);
            else XB_SPIN(xb_ld(&bar[XB_TOPGEN]) == tg, bar);
            __builtin_amdgcn_fence(__ATOMIC_ACQUIRE, "agent");
            xb_add(&bar[XB_XGEN(b.x)], 1u);
            asm volatile("s_waitcnt vmcnt(0)" ::: "memory");
        } else {
            XB_SPIN(xb_ld(&bar[XB_XGEN(b.x)]) == gen, bar);
            __builtin_amdgcn_fence(__ATOMIC_ACQUIRE, "agent");
            asm volatile("s_waitcnt vmcnt(0)" ::: "memory");
        }
    }
    __syncthreads();
}

namespace pg8 {
constexpr int BM = 256, BK = 64, HALF = 128, HTB = HALF * BK * 2, STAGE_BYTES = 8 * HTB, NXCD = 8, WGM = 8;
__host__ __device__ __forceinline__ int lds_byte(int r, int c) { const int st = (r >> 4) * 2 + (c >> 5), rr = r & 15, cc = c & 31, ob = rr * 64 + cc * 2; return st * 1024 + (ob ^ (((ob >> 9) & 1) << 5)); }
__host__ __device__ __forceinline__ void stage_rc(int b, int& R_, int& C) { const int st = b / 1024, sb = b % 1024, swz = sb ^ (((sb >> 9) & 1) << 5); R_ = (st >> 1) * 16 + swz / 64; C = (st & 1) * 32 + (swz % 64) / 2; }
__host__ __device__ __forceinline__ int perm32(int rho) { const int n = rho >> 4, i = rho & 15; return 8 * (i >> 2) + 4 * n + (i & 3); }
struct Unit { int pm, pn; };
struct Gemm { const bf16_t* A; const bf16_t* Bt; int lda, ldb, K; };
struct StaticOrder {
    int nM, nN, nwg, G, c;
    __device__ void init(int M, int N, int G_, int c_) { nM = M / BM; nN = N / BM; nwg = nM * nN; G = G_; c = c_; }
    __device__ bool next(int i, Unit& u) const {
        const long L = (long)i * G + c; if (L >= nwg) return false;
        int wgid = (int)L; { const int q = nwg / NXCD, r = nwg % NXCD, xcd = wgid % NXCD, off = wgid / NXCD; wgid = (xcd < r ? xcd * (q + 1) : r * (q + 1) + (xcd - r) * q) + off; }
        const int nig = WGM * nN, gid = wgid / nig, fm = gid * WGM, gsz = (nM - fm) < WGM ? (nM - fm) : WGM;
        const int pml = fm + ((wgid % nig) % gsz); u.pm = pml + 1 + (pml >> 6);
        u.pn = (wgid % nig) / gsz; return true;
    }
    __device__ __forceinline__ size_t a_off(const Unit&) const { return 0; }
};
struct GroupOrder : StaticOrder {
    __device__ __forceinline__ size_t a_off(const Unit& u) const { return (size_t)(u.pn >> 1) * 256 * 2; }
};

template <class Epi, class Sched>
__device__ __forceinline__ void gemm_phase(LAS unsigned char* lds, const Gemm g, const Sched& S, const Epi& E, const int wid0) {
    const int tid = opaque_tid(wid0), wid = __builtin_amdgcn_readfirstlane(tid >> 6), lane = tid & 63, wr = wid >> 2, wc = wid & 3, fr = lane & 15, fq = lane >> 4;
    int K = g.K; asm volatile("" : "+s"(K));
    const int nt = K / BK;
    unsigned voffA[2], voffB[2];
#pragma unroll
    for (int i = 0; i < 2; ++i) { int R_, C; stage_rc(tid * 16 + i * 8192, R_, C); const int Rb = Epi::PERM ? ((R_ & ~31) + perm32(R_ & 31)) : R_;
        voffA[i] = (unsigned)(R_ * g.lda + C) * 2u; voffB[i] = (unsigned)(Rb * g.ldb + C) * 2u; }
    const size_t kstep = (size_t)(BK * 2);
    const size_t hstepA = (size_t)HALF * g.lda * 2, hstepB = (size_t)HALF * g.ldb * 2;
    const size_t tstepA = 2 * hstepA, tstepB = 2 * hstepB;
    const unsigned ldsw = (unsigned)wid * 1024u;
    const int aoff = lds_byte(wr * 64 + fr, fq * 8), boff = lds_byte(wc * 32 + fr, fq * 8);
#define PG8_SA(b, h) (((b) * 2 + (h)) * HTB)
#define PG8_SB(b, h) ((4 + (b) * 2 + (h)) * HTB)
#define PG8_STAGE(bufoff, gbase, voff) do { _Pragma("unroll") for (int _i = 0; _i < 2; ++_i) \
        __builtin_amdgcn_global_load_lds((const unsigned*)((const char*)(gbase) + (voff)[_i]), (LAS unsigned*)(lds + (bufoff) + ldsw + _i * 8192), 16, 0, 0); } while (0)
#define PG8_LDA(dst, b, h) do { _Pragma("unroll") for (int m = 0; m < 4; ++m) _Pragma("unroll") for (int k = 0; k < 2; ++k) dst[m][k] = *(const LAS bf16x8*)(lds + PG8_SA(b, h) + aoff + m * 2048 + k * 1024); } while (0)
#define PG8_LDB(dst, b, h) do { _Pragma("unroll") for (int n = 0; n < 2; ++n) _Pragma("unroll") for (int k = 0; k < 2; ++k) dst[n][k] = *(const LAS bf16x8*)(lds + PG8_SB(b, h) + boff + n * 2048 + k * 1024); } while (0)
#define PG8_MMA(ai, bj, At, Bt) do { __builtin_amdgcn_s_setprio(1); _Pragma("unroll") for (int m = 0; m < 4; ++m) _Pragma("unroll") for (int n = 0; n < 2; ++n) _Pragma("unroll") for (int k = 0; k < 2; ++k) \
        acc[ai][bj][m][n] = __builtin_amdgcn_mfma_f32_16x16x32_bf16(Bt[n][k], At[m][k], acc[ai][bj][m][n], 0, 0, 0); __builtin_amdgcn_s_setprio(0); } while (0)
#define PG8_WAIT_V(n) asm volatile("s_waitcnt vmcnt(" #n ")" ::: "memory")
#define PG8_WAIT_L(n) asm volatile("s_waitcnt lgkmcnt(" #n ")" ::: "memory")
#define PG8_BAR __builtin_amdgcn_s_barrier()
#define PG8_SCHED __builtin_amdgcn_sched_barrier(0)
    Unit cur, nxt; int ui = 0;
    if (!S.next(0, cur)) return;
    f32x4 acc[2][2][4][2];
#pragma unroll
    for (int a = 0; a < 2; ++a)
#pragma unroll
        for (int b = 0; b < 2; ++b)
#pragma unroll
            for (int m = 0; m < 4; ++m)
#pragma unroll
                for (int n = 0; n < 2; ++n) acc[a][b][m][n] = (f32x4){0.f, 0.f, 0.f, 0.f};
    bf16x8 At[4][2], B0[2][2], B1[2][2];
    const char* cA = (const char*)g.A + (size_t)cur.pm * tstepA + S.a_off(cur); const char* cB = (const char*)g.Bt + (size_t)cur.pn * tstepB;
    PG8_STAGE(PG8_SB(0, 0), cB, voffB); PG8_STAGE(PG8_SB(0, 1), cB + hstepB, voffB); PG8_STAGE(PG8_SA(0, 0), cA, voffA); PG8_STAGE(PG8_SA(0, 1), cA + hstepA, voffA);
    if (wr == 1) PG8_BAR;
    PG8_WAIT_V(2); PG8_BAR;
    PG8_STAGE(PG8_SB(1, 0), cB + kstep, voffB); PG8_STAGE(PG8_SA(1, 0), cA + kstep, voffA); PG8_STAGE(PG8_SB(1, 1), cB + hstepB + kstep, voffB);
    PG8_WAIT_V(6); PG8_BAR;
    for (;;) {
        const bool has_next = S.next(ui + 1, nxt);
        const char* nA = has_next ? (const char*)g.A + (size_t)nxt.pm * tstepA + S.a_off(nxt) : cA; const char* nB = has_next ? (const char*)g.Bt + (size_t)nxt.pn * tstepB : cB;
        for (int t = 0; t < nt; t += 2) {
            const bool last = (t == nt - 2);
            const char* a1 = cA + (size_t)(t + 1) * kstep;
            const char* a2 = last ? nA : cA + (size_t)(t + 2) * kstep; const char* b2 = last ? nB : cB + (size_t)(t + 2) * kstep;
            const char* a3 = a2 + kstep; const char* b3 = b2 + kstep;
            PG8_LDB(B0, 0, 0); PG8_LDB(B1, 0, 1); PG8_SCHED; PG8_LDA(At, 0, 0); PG8_STAGE(PG8_SA(1, 1), a1 + hstepA, voffA);
            PG8_WAIT_V(8); PG8_WAIT_L(0); PG8_BAR; PG8_MMA(0, 0, At, B0); PG8_MMA(0, 1, At, B1); PG8_BAR; PG8_SCHED;
            PG8_LDA(At, 0, 1); PG8_STAGE(PG8_SB(0, 0), b2, voffB); PG8_STAGE(PG8_SB(0, 1), b2 + hstepB, voffB); PG8_STAGE(PG8_SA(0, 0), a2, voffA);
            PG8_WAIT_V(8); PG8_WAIT_L(0); PG8_BAR; PG8_MMA(1, 0, At, B0); PG8_MMA(1, 1, At, B1); PG8_BAR; PG8_SCHED;
            PG8_LDB(B0, 1, 0); PG8_LDB(B1, 1, 1); PG8_SCHED; PG8_LDA(At, 1, 0); PG8_STAGE(PG8_SA(0, 1), a2 + hstepA, voffA);
            PG8_WAIT_V(8); PG8_WAIT_L(0); PG8_BAR; PG8_MMA(0, 0, At, B0); PG8_MMA(0, 1, At, B1); PG8_BAR; PG8_SCHED;
            PG8_LDA(At, 1, 1); PG8_STAGE(PG8_SB(1, 0), b3, voffB); PG8_STAGE(PG8_SB(1, 1), b3 + hstepB, voffB); PG8_STAGE(PG8_SA(1, 0), a3, voffA);
            PG8_WAIT_V(8); PG8_WAIT_L(0); PG8_BAR; PG8_MMA(1, 0, At, B0); PG8_MMA(1, 1, At, B1); PG8_BAR; PG8_SCHED;
        }
        if (wr == 0) PG8_BAR;
        E(acc, cur, wr, wc, fr, fq);
        if (!has_next) break;
#pragma unroll
        for (int a = 0; a < 2; ++a)
#pragma unroll
            for (int b = 0; b < 2; ++b)
#pragma unroll
                for (int m = 0; m < 4; ++m)
#pragma unroll
                    for (int n = 0; n < 2; ++n) acc[a][b][m][n] = (f32x4){0.f, 0.f, 0.f, 0.f};
        cur = nxt; cA = nA; cB = nB; ++ui;
        if (wr == 1) PG8_BAR;
    }
    PG8_WAIT_V(0);
    PG8_BAR;
#undef PG8_SA
#undef PG8_SB
#undef PG8_STAGE
#undef PG8_LDA
#undef PG8_LDB
#undef PG8_MMA
#undef PG8_WAIT_V
#undef PG8_WAIT_L
#undef PG8_BAR
#undef PG8_SCHED
}

struct EpiProj {
    static constexpr bool PERM = true;
    bf16_t* d0; bf16_t* d1; bf16_t* d2; bf16_t* d3; bf16_t* qi; bf16_t* ki; float* wi;
    __device__ __forceinline__ void operator()(const f32x4 (&acc)[2][2][4][2], const Unit& u, int wr, int wc, int fr, int fq) const {
        const int row0 = u.pm * BM + wr * 64 + fr;
#pragma unroll
        for (int bj = 0; bj < 2; ++bj) {
            const int colb = u.pn * BM + bj * HALF + wc * 32 + 8 * fq;
            bf16_t* base; int ld, c; bool isf = false, skip = false;
            if (colb < 4096) { const int t = colb >> 10; base = t == 0 ? d0 : t == 1 ? d1 : t == 2 ? d2 : d3; ld = 1024; c = colb & 1023; }
            else if (colb < 4608) { base = qi; ld = 512; c = colb - 4096; }
            else if (colb < 4672) { base = ki; ld = 64; c = colb - 4608; }
            else if (colb == 4672) { base = nullptr; ld = 8; c = 0; isf = true; }
            else { base = nullptr; ld = 0; c = 0; skip = true; }
            if (skip) continue;
#pragma unroll
            for (int ai = 0; ai < 2; ++ai)
#pragma unroll
                for (int m = 0; m < 4; ++m) { const int row = row0 + ai * HALF + m * 16; const f32x4 v0 = acc[ai][bj][m][0], v1 = acc[ai][bj][m][1];
                    if (isf) { float* p = wi + (size_t)row * 8; *(f32x4*)p = v0; *(f32x4*)(p + 4) = v1; }
                    else { u32x4 w; w.x = cvt_pk_bf16(v0[0], v0[1]); w.y = cvt_pk_bf16(v0[2], v0[3]); w.z = cvt_pk_bf16(v1[0], v1[1]); w.w = cvt_pk_bf16(v1[2], v1[3]);
                        *(u32x4*)(base + (size_t)row * ld + c) = w; } }
        }
    }
};
struct EpiRes {
    static constexpr bool PERM = false;
    float* out; float* hmeta; int dry; long sdelta;
    __device__ __forceinline__ void operator()(const f32x4 (&acc)[2][2][4][2], const Unit& u, int wr, int wc, int fr, int fq) const {
        if (dry) return;
        const int row0 = u.pm * BM + wr * 64 + fr, col0 = u.pn * BM + wc * 32 + 4 * fq;
#pragma unroll
        for (int ai = 0; ai < 2; ++ai)
#pragma unroll
            for (int m = 0; m < 4; ++m) { float* rowp = hrow(out, hmeta, row0 + ai * HALF + m * 16) + col0;
#pragma unroll
                for (int bj = 0; bj < 2; ++bj)
#pragma unroll
                    for (int n = 0; n < 2; ++n) { f32x4* p = (f32x4*)(rowp + bj * HALF + n * 16); *p = *(const f32x4*)((const float*)p + sdelta) + acc[ai][bj][m][n]; } }
    }
};
struct EpiRelu2 {
    static constexpr bool PERM = true;
    bf16_t* O; int ldc;
    __device__ __forceinline__ void operator()(const f32x4 (&acc)[2][2][4][2], const Unit& u, int wr, int wc, int fr, int fq) const {
        const int row0 = u.pm * BM + wr * 64 + fr, col0 = u.pn * BM + wc * 32 + 8 * fq;
#pragma unroll
        for (int ai = 0; ai < 2; ++ai)
#pragma unroll
            for (int m = 0; m < 4; ++m) { bf16_t* rowp = O + (size_t)(row0 + ai * HALF + m * 16) * ldc + col0;
#pragma unroll
                for (int bj = 0; bj < 2; ++bj) { f32x4 v0 = acc[ai][bj][m][0], v1 = acc[ai][bj][m][1];
#pragma unroll
                    for (int j = 0; j < 4; ++j) { const float a = fmaxf(v0[j], 0.f), b = fmaxf(v1[j], 0.f); v0[j] = a * a; v1[j] = b * b; }
                    u32x4 w; w.x = cvt_pk_bf16(v0[0], v0[1]); w.y = cvt_pk_bf16(v0[2], v0[3]); w.z = cvt_pk_bf16(v1[0], v1[1]); w.w = cvt_pk_bf16(v1[2], v1[3]);
                    *(u32x4*)(rowp + bj * HALF) = w; } }
    }
};
struct EpiRGPre {
    static constexpr bool PERM = true;
    bf16_t* PA; bf16_t* PX;
    __device__ __forceinline__ void operator()(const f32x4 (&acc)[2][2][4][2], const Unit& u, int wr, int wc, int fr, int fq) const {
        const int row0 = u.pm * BM + wr * 64 + fr, col0 = (u.pn >> 1) * 256 + wc * 32 + 8 * fq;
        bf16_t* base = (bf16_t*)((char*)PA + ((u.pn & 1) ? (size_t)((const char*)PX - (const char*)PA) : (size_t)0));
#pragma unroll
        for (int ai = 0; ai < 2; ++ai)
#pragma unroll
            for (int m = 0; m < 4; ++m) { bf16_t* rowp = base + (size_t)(row0 + ai * HALF + m * 16) * D + col0;
#pragma unroll
                for (int bj = 0; bj < 2; ++bj) { const f32x4 v0 = acc[ai][bj][m][0], v1 = acc[ai][bj][m][1];
                    u32x4 w; w.x = cvt_pk_bf16(v0[0], v0[1]); w.y = cvt_pk_bf16(v0[2], v0[3]); w.z = cvt_pk_bf16(v1[0], v1[1]); w.w = cvt_pk_bf16(v1[2], v1[3]);
                    *(u32x4*)(rowp + bj * HALF) = w; } }
    }
};
}

template <class Epi>
__device__ __forceinline__ void meta_gemm(LAS unsigned char* lds, const bf16_t* A, int lda, const bf16_t* Bt, int ldb, int N, int K, int wgsplit, int ngroups, const Epi& epi, const int wid0) {
    const int tid = opaque_tid(wid0), lane = tid & 63, wid = __builtin_amdgcn_readfirstlane(tid >> 6), m16 = lane & 15, kq = lane >> 4;
    const int ncg = N / 16, Kw = K / wgsplit, Kv = Kw / NWAVES, ntask = ncg * wgsplit, cpg = ncg / ngroups;
    LAS float* part = (LAS float*)lds;
    for (int task = (int)gridDim.x - 1 - (int)blockIdx.x; task < ntask; task += (int)gridDim.x) {
        const int cg = task % ncg, kc = task / ncg, n0 = cg * 16, grp = cg / cpg, kbase = kc * Kw + wid * Kv;
        const bf16_t* a0 = A + (size_t)(PADF + m16) * lda + (size_t)grp * 256 * (ngroups > 1) + kbase + 8 * kq;
        const bf16_t* a1 = a0 + (size_t)RA * lda;
        const bf16_t* bp = Bt + (size_t)(n0 + m16) * ldb + kbase + 8 * kq;
        f32x4 acc0 = {0.f, 0.f, 0.f, 0.f}, acc1 = {0.f, 0.f, 0.f, 0.f};
#pragma unroll 4
        for (int k0 = 0; k0 < Kv; k0 += 32) {
            const bf16x8 fa0 = *(const bf16x8*)(a0 + k0), fa1 = *(const bf16x8*)(a1 + k0), fb = *(const bf16x8*)(bp + k0);
            acc0 = __builtin_amdgcn_mfma_f32_16x16x32_bf16(fa0, fb, acc0, 0, 0, 0);
            acc1 = __builtin_amdgcn_mfma_f32_16x16x32_bf16(fa1, fb, acc1, 0, 0, 0);
        }
        *(LAS f32x4*)(part + (wid * 64 + lane) * 8) = acc0; *(LAS f32x4*)(part + (wid * 64 + lane) * 8 + 4) = acc1;
        __syncthreads();
        {
            const int m = tid >> 4, n = tid & 15, src = ((((m & 15) >> 2) * 16 + n) * 8) + (m >> 4) * 4 + (m & 3);
            float v = 0.f;
#pragma unroll
            for (int w = 0; w < NWAVES; ++w) v += part[w * 512 + src];
            epi((m >> 4) * RA + PADF + (m & 15), n0 + n, v);
        }
        __syncthreads();
    }
}
struct MEpiProj { bf16_t* d0; bf16_t* d1; bf16_t* d2; bf16_t* d3; bf16_t* qi; bf16_t* ki; float* wi;
    __device__ __forceinline__ void operator()(int row, int col, float v) const {
        if (col < 4096) { const int t = col >> 10; bf16_t* base = t == 0 ? d0 : t == 1 ? d1 : t == 2 ? d2 : d3; base[(size_t)row * 1024 + (col & 1023)] = (bf16_t)(cvt_pk_bf16(v, 0.f) & 0xffffu); }
        else if (col < 4608) qi[(size_t)row * 512 + (col - 4096)] = (bf16_t)(cvt_pk_bf16(v, 0.f) & 0xffffu);
        else if (col < 4672) ki[(size_t)row * 64 + (col - 4608)] = (bf16_t)(cvt_pk_bf16(v, 0.f) & 0xffffu);
        else if (col < 4680) wi[(size_t)row * 8 + (col - 4672)] = v;
    } };
struct MEpiRG { bf16_t* PA; bf16_t* PX;
    __device__ __forceinline__ void operator()(int row, int col, float v) const { const int g = col >> 9, c = col & 511; bf16_t* base = (bf16_t*)((char*)PA + ((c & 256) ? (size_t)((const char*)PX - (const char*)PA) : (size_t)0)); base[(size_t)row * 1024 + g * 256 + (c & 255)] = (bf16_t)(cvt_pk_bf16(v, 0.f) & 0xffffu); } };
struct MEpiRes { float* out; float* hmeta;
    __device__ __forceinline__ void operator()(int row, int col, float v) const { atomicAdd(hrow(out, hmeta, row) + col, v); } };
struct MEpiRelu2 { bf16_t* O;
    __device__ __forceinline__ void operator()(int row, int col, float v) const { const float a = fmaxf(v, 0.f); O[(size_t)row * FF + col] = (bf16_t)(cvt_pk_bf16(a * a, 0.f) & 0xffffu); } };

struct Args {
    const float* x; const float* norm1_g; const float* w_in; const float* conv_w; const float* conv_b;
    const float* w_rg_a; const float* b_rg_a; const float* w_rg_x; const float* b_rg_x; const float* lru_lambda;
    const float* w_out; const float* norm2_g; const float* w_mlp1; const float* w_mlp2; const float* rel_bias;
    const float* meta; const float* final_g; float* out; unsigned char* ws; int ph_lo, ph_hi;
};

__device__ __forceinline__ void transpose_item(const float* W, int ldw, int K, int kb, int src_col0, int nvalid, bf16_t* WT, int dst_row0, int dst_stride, LAS float* scr, int lane, const float wscale = 1.0f) {
    const int k0 = 64 * kb, c4 = (lane & 7) * 4;
    f32x4 ld[8];
#pragma unroll
    for (int i = 0; i < 8; ++i) { const int kk = (lane >> 3) + 8 * i; ld[i] = (c4 < nvalid) ? *(const f32x4*)(W + (size_t)(k0 + kk) * ldw + src_col0 + c4) : (f32x4){0.f, 0.f, 0.f, 0.f}; }
#pragma unroll
    for (int i = 0; i < 8; ++i) { const int kk = (lane >> 3) + 8 * i;
#pragma unroll
        for (int j = 0; j < 4; ++j) scr[kk * 33 + c4 + j] = ld[i][j] * wscale; }
    asm volatile("s_waitcnt lgkmcnt(0)" ::: "memory");
    const int c8 = lane & 7;
#pragma unroll
    for (int j = 0; j < 4; ++j) { const int n = (lane >> 3) + 8 * j; const LAS float* s = scr + (8 * c8) * 33 + n;
        u32x4 o; o.x = cvt_pk_bf16(s[0 * 33], s[1 * 33]); o.y = cvt_pk_bf16(s[2 * 33], s[3 * 33]); o.z = cvt_pk_bf16(s[4 * 33], s[5 * 33]); o.w = cvt_pk_bf16(s[6 * 33], s[7 * 33]);
        *(u32x4*)(WT + (size_t)(dst_row0 + n * dst_stride) * K + k0 + 8 * c8) = o; }
    asm volatile("s_waitcnt lgkmcnt(0)" ::: "memory");
}
__device__ __forceinline__ int win_src(int drow, int& nvalid) {
    nvalid = 32;
    if (drow < 2048) return drow;
    if (drow < 3072) return 5704 + (drow - 2048);
    const int j = drow - 3072;
    if (j < 1024) return 2048 + j;
    if (j < 2048) return 3072 + (j - 1024);
    if (j < 3072) return 4096 + (j - 2048);
    if (j < 4096) return 6728 + (j - 3072);
    if (j < 4608) return 5120 + (j - 4096);
    if (j < 4672) return 5632 + (j - 4608);
    if (j == 4672) { nvalid = 8; return 5696; }
    nvalid = 0; return 0;
}
__device__ __forceinline__ int t5_bucket(int d) {
    if (d < 16) return d;
    int v = 16 + (int)(logf((float)d / 16.0f) / logf(8.0f) * 16.0f);
    return v > 31 ? 31 : v;
}
__device__ __forceinline__ void phase_prologue(const Args& A, LAS unsigned char* lds, const int wid0) {
    const int tid = opaque_tid(wid0), lane = tid & 63, wave = __builtin_amdgcn_readfirstlane(tid >> 6), gw = blockIdx.x * NWAVES + wave, NGW = gridDim.x * NWAVES;
    LAS float* scr = (LAS float*)(lds + wave * 16384);
    constexpr int I_IN = (WIN_ROWS / 32) * 16, I_OUT = 32 * 16, I_1 = 128 * 16, I_2 = 32 * 64, I_RG = 2 * 4 * 8 * 4, I_L = I_IN + I_OUT + I_1 + I_2 + I_RG;
    for (int it = gw; it < DEPTH * I_L; it += NGW) {
        const int l = it / I_L; int r = it - l * I_L;
        if (r < I_IN) { const int rb = r >> 4, kb = r & 15; int nv; const int sc = win_src(rb * 32, nv);
            transpose_item(A.w_in + (size_t)l * D * NIN, NIN, D, kb, sc, nv, (bf16_t*)(A.ws + WS_WIN + (size_t)l * 16 * MiB), rb * 32, 1, scr, lane, (rb >= 96 && rb < 128) ? 0.12751743f : 1.0f); continue; }
        r -= I_IN;
        if (r < I_OUT) { transpose_item(A.w_out + (size_t)l * D * D, D, D, r & 15, (r >> 4) * 32, 32, (bf16_t*)(A.ws + WS_WOUT + (size_t)l * 2 * MiB), (r >> 4) * 32, 1, scr, lane); continue; }
        r -= I_OUT;
        if (r < I_1) { transpose_item(A.w_mlp1 + (size_t)l * D * FF, FF, D, r & 15, (r >> 4) * 32, 32, (bf16_t*)(A.ws + WS_W1 + (size_t)l * 8 * MiB), (r >> 4) * 32, 1, scr, lane); continue; }
        r -= I_1;
        if (r < I_2) { transpose_item(A.w_mlp2 + (size_t)l * FF * D, D, FF, r & 63, (r >> 6) * 32, 32, (bf16_t*)(A.ws + WS_W2 + (size_t)l * 8 * MiB), (r >> 6) * 32, 1, scr, lane); continue; }
        r -= I_2;
        { const int mat = r >> 7, g = (r >> 5) & 3, nb = (r >> 2) & 7, kb = r & 3;
          const float* W = (mat ? A.w_rg_x : A.w_rg_a) + ((size_t)l * 4 + g) * 65536;
          transpose_item(W, 256, 256, kb, nb * 32, 32, (bf16_t*)(A.ws + WS_WRG + (size_t)l * MiB) + (size_t)g * 512 * 256, mat * 256 + nb * 32, 1, scr, lane); }
    }
    if (gw == 0) {
        float* lut = (float*)(A.ws + WS_LUT);
        for (int i = lane; i < NH * 128; i += 64) { const int h = i >> 7, d = i & 127;
            lut[i] = (A.rel_bias[t5_bucket(d) * NH + h] - A.rel_bias[31 * NH + h]) * 1.4426950408889634f; }
    }
}

template <int MODE>
__device__ __forceinline__ void phase_rmsnorm(const Args& A, const float* gain, bf16_t* XN, const int wid0, bf16_t* Z0 = nullptr, bf16_t* Z1 = nullptr) {
    const int tid = opaque_tid(wid0), lane = tid & 63, wave = __builtin_amdgcn_readfirstlane(tid >> 6), gw = blockIdx.x * NWAVES + wave, NGW = gridDim.x * NWAVES;
    if (Z0) {
        for (int i = gw; i < 2 * NB * 48; i += NGW) { bf16_t* base = (i & 1) ? Z1 : Z0; const int rr = i >> 1, b = rr / 48, a = 192 + rr % 48; u32x2* o = (u32x2*)(base + ((size_t)b * RA + a) * D) + lane;
#pragma unroll
            for (int j = 0; j < 4; ++j) o[64 * j] = (u32x2){0u, 0u}; } }
    float* hmeta = (float*)(A.ws + WS_HMETA);
    f32x4 gv[4];
#pragma unroll
    for (int j = 0; j < 4; ++j) gv[j] = *((const f32x4*)gain + lane + 64 * j);
    for (int row0 = gw; row0 < R; row0 += 2 * NGW) {
        f32x4 v[2][4]; bool act[2] = {false, false}; float* hp[2] = {nullptr, nullptr};
#pragma unroll
        for (int rr = 0; rr < 2; ++rr) {
            const int row = row0 + rr * NGW;
            if (row >= R) continue;
            const int b = row >= RA ? 1 : 0, a = row - b * RA;
            if (a < PADF) {
                if (MODE != 2) { u32x2* o = (u32x2*)(XN + (size_t)row * D) + lane;
#pragma unroll
                    for (int j = 0; j < 4; ++j) o[64 * j] = (u32x2){0u, 0u}; }
                if (MODE == 0) { f32x4* hz = (f32x4*)hrow(A.out, hmeta, row) + lane;
#pragma unroll
                    for (int j = 0; j < 4; ++j) hz[64 * j] = (f32x4){0.f, 0.f, 0.f, 0.f}; }
                continue;
            }
            if (MODE == 2 && a < 256) continue;
            act[rr] = true; hp[rr] = hrow(A.out, hmeta, row);
            const float* src = hp[rr];
            if (MODE == 0) src = (a < 256) ? A.meta + (size_t)(a - PADF) * D : A.x + ((size_t)(b * SEQ + a - 256) << 10);
#pragma unroll
            for (int j = 0; j < 4; ++j) v[rr][j] = *((const f32x4*)src + lane + 64 * j);
        }
#pragma unroll
        for (int rr = 0; rr < 2; ++rr) {
            if (!act[rr]) continue;
            const int row = row0 + rr * NGW;
            float s = 0.f;
#pragma unroll
            for (int j = 0; j < 4; ++j) s += (v[rr][j].x * v[rr][j].x + v[rr][j].y * v[rr][j].y) + (v[rr][j].z * v[rr][j].z + v[rr][j].w * v[rr][j].w);
            const float rstd = 1.0f / sqrtf(wave_sum(s) * (1.0f / D) + EPS);
            if (MODE == 0 && row - (row >= RA ? RA : 0) < 256) {
#pragma unroll
                for (int j = 0; j < 4; ++j) *((f32x4*)hp[rr] + lane + 64 * j) = v[rr][j]; }
            if (MODE == 2) {
#pragma unroll
                for (int j = 0; j < 4; ++j) *((f32x4*)hp[rr] + lane + 64 * j) = v[rr][j] * rstd * gv[j];
            } else {
                u32x2* o = (u32x2*)(XN + (size_t)row * D) + lane;
#pragma unroll
                for (int j = 0; j < 4; ++j) { const f32x4 y = v[rr][j] * rstd * gv[j]; o[64 * j] = (u32x2){cvt_pk_bf16(y.x, y.y), cvt_pk_bf16(y.z, y.w)}; }
            }
        }
    }
}

__device__ __forceinline__ void phase_conv(const bf16_t* U, bf16_t* XC, const float* cw, const float* cb, int G, const int wid0) {
    const int t_ = opaque_tid(wid0), ch = (t_ & 255) * 4, us = t_ >> 8;
    f32x4 w[4];
#pragma unroll
    for (int j = 0; j < 4; ++j) w[j] = *(const f32x4*)(cw + j * D + ch);
    const f32x4 bb = *(const f32x4*)(cb + ch);
    for (int unit = blockIdx.x * 2 + us; unit < NB * NCHUNK; unit += 2 * G) {
        const int b = unit / NCHUNK, c = unit - b * NCHUNK; const size_t r0 = (size_t)b * RA + c * CHROWS;
        f32x4 x0 = {0.f, 0.f, 0.f, 0.f}, x1 = x0, x2 = x0;
        if (c * CHROWS - 3 >= PADF) { const u32x2 q = *(const u32x2*)(U + (r0 - 3) * D + ch); x0 = (f32x4){bf_lo(q.x), bf_hi(q.x), bf_lo(q.y), bf_hi(q.y)}; }
        if (c * CHROWS - 2 >= PADF) { const u32x2 q = *(const u32x2*)(U + (r0 - 2) * D + ch); x1 = (f32x4){bf_lo(q.x), bf_hi(q.x), bf_lo(q.y), bf_hi(q.y)}; }
        if (c * CHROWS - 1 >= PADF) { const u32x2 q = *(const u32x2*)(U + (r0 - 1) * D + ch); x2 = (f32x4){bf_lo(q.x), bf_hi(q.x), bf_lo(q.y), bf_hi(q.y)}; }
#pragma unroll 5
        for (int i = 0; i < CHROWS; ++i) {
            const size_t off = (r0 + i) * D + ch;
            const bool live = c * CHROWS + i >= PADF;
            f32x4 x3 = {0.f, 0.f, 0.f, 0.f};
            if (live) { const u32x2 q = *(const u32x2*)(U + off); x3 = (f32x4){bf_lo(q.x), bf_hi(q.x), bf_lo(q.y), bf_hi(q.y)}; }
            const f32x4 acc = bb + w[0] * x0 + w[1] * x1 + w[2] * x2 + w[3] * x3;
            u32x2 o = {0u, 0u};
            if (live) { o.x = cvt_pk_bf16(acc.x, acc.y); o.y = cvt_pk_bf16(acc.z, acc.w); }
            *(u32x2*)(XC + off) = o;
            x0 = x1; x1 = x2; x2 = x3;
        }
    }
}

__device__ __forceinline__ float nexpm1_fast(float x) {
    const float e = 1.0f - __expf(x), p = -x * (1.0f + x * (0.5f + x * 0.16666667f));
    return x > -0.01f ? p : e;
}
__device__ __forceinline__ void phase_scan_local(bf16_t* PA, bf16_t* PX, const bf16_t* XC, const float* ba, const float* bx, const float* lam, float* AGG, int G, const bool dry, const int wid0) {
    const int t_ = opaque_tid(wid0), ch = (t_ & 255) * 4, us = t_ >> 8;
    const f32x4 bav = *(const f32x4*)(ba + ch), bxv = *(const f32x4*)(bx + ch), lmv = *(const f32x4*)(lam + ch);
    float sp[4];
#pragma unroll
    for (int k = 0; k < 4; ++k) sp[k] = -8.0f * log1pf(__expf(-lmv[k]));
    for (int unit = blockIdx.x * 2 + us; unit < NB * NCHUNK; unit += 2 * G) {
        const int b = unit / NCHUNK, c = unit - b * NCHUNK; const size_t r0 = (size_t)b * RA + c * CHROWS;
        float Ac[4] = {1.f, 1.f, 1.f, 1.f}, Hc[4] = {0.f, 0.f, 0.f, 0.f};
#pragma unroll 5
        for (int i = 0; i < CHROWS; ++i) {
            const size_t off = (r0 + i) * D + ch;
            const u32x2 pa = *(const u32x2*)(PA + off), px = *(const u32x2*)(PX + off), xc = *(const u32x2*)(XC + off);
            float l[4], v[4];
            l[0] = sigm_fast(bf_lo(pa.x) + bav[0]) * sp[0]; l[1] = sigm_fast(bf_hi(pa.x) + bav[1]) * sp[1]; l[2] = sigm_fast(bf_lo(pa.y) + bav[2]) * sp[2]; l[3] = sigm_fast(bf_hi(pa.y) + bav[3]) * sp[3];
            v[0] = sigm_fast(bf_lo(px.x) + bxv[0]) * bf_lo(xc.x); v[1] = sigm_fast(bf_hi(px.x) + bxv[1]) * bf_hi(xc.x); v[2] = sigm_fast(bf_lo(px.y) + bxv[2]) * bf_lo(xc.y); v[3] = sigm_fast(bf_hi(px.y) + bxv[3]) * bf_hi(xc.y);
            if (c * CHROWS + i < PADF) {
#pragma unroll
                for (int k = 0; k < 4; ++k) { l[k] = 0.f; v[k] = 0.f; } }
            h16x4 lh, vh;
#pragma unroll
            for (int k = 0; k < 4; ++k) { lh[k] = (_Float16)l[k]; vh[k] = (_Float16)v[k]; }
            if (!dry) { *(h16x4*)(PA + off) = lh; *(h16x4*)(PX + off) = vh; }
#pragma unroll
            for (int k = 0; k < 4; ++k) { const float lr = (float)lh[k], vr = (float)vh[k];
                const float ak = __expf(lr); Hc[k] = ak * Hc[k] + __builtin_amdgcn_sqrtf(nexpm1_fast(2.0f * lr)) * vr; Ac[k] *= ak; }
        }
        if (!dry) { *(f32x4*)(AGG + (size_t)unit * D + ch) = (f32x4){Ac[0], Ac[1], Ac[2], Ac[3]};
            *(f32x4*)(AGG + (size_t)(NB * NCHUNK + unit) * D + ch) = (f32x4){Hc[0], Hc[1], Hc[2], Hc[3]}; }
    }
}
__device__ __forceinline__ void phase_scan_carry(const float* AGG, float* CARRY, const int wid0) {
    const int tid = opaque_tid(wid0), lane = tid & 63, wave = __builtin_amdgcn_readfirstlane(tid >> 6), gw = blockIdx.x * NWAVES + wave, NGW = gridDim.x * NWAVES;
    for (int t = gw; t < NB * D; t += NGW) {
        const int b = t >> 10, ch = t & 1023;
        float a[4], hh[4];
#pragma unroll
        for (int i = 0; i < 4; ++i) { const size_t u = (size_t)(b * NCHUNK + 4 * lane + i); a[i] = AGG[u * D + ch]; hh[i] = AGG[((size_t)NB * NCHUNK + u) * D + ch]; }
        float Am = a[0], Bm = hh[0];
#pragma unroll
        for (int i = 1; i < 4; ++i) { Bm = a[i] * Bm + hh[i]; Am *= a[i]; }
#pragma unroll
        for (int off = 1; off < 64; off <<= 1) { const float Ap = __shfl_up(Am, off), Bp = __shfl_up(Bm, off); if (lane >= off) { Bm = Am * Bp + Bm; Am = Am * Ap; } }
        float h = __shfl_up(Bm, 1); if (lane == 0) h = 0.f;
#pragma unroll
        for (int i = 0; i < 4; ++i) { CARRY[(size_t)(b * NCHUNK + 4 * lane + i) * D + ch] = h; h = a[i] * h + hh[i]; }
    }
}
__device__ __forceinline__ float gelu_fast(float x) { const float z = 0.7978845608028654f * (x + 0.044715f * x * x * x); return x * __builtin_amdgcn_rcpf(1.0f + __expf(-2.0f * z)); }
__device__ __forceinline__ void phase_scan_apply(const _Float16* LA, const _Float16* V, const float* CARRY, const bf16_t* UG, const bf16_t* GR, bf16_t* Y, int G, const int wid0) {
    const int t_ = opaque_tid(wid0), ch = (t_ & 255) * 4, us = t_ >> 8;
    for (int unit = blockIdx.x * 2 + us; unit < NB * NCHUNK; unit += 2 * G) {
        const int b = unit / NCHUNK, c = unit - b * NCHUNK; const size_t r0 = (size_t)b * RA + c * CHROWS;
        const f32x4 hc = *(const f32x4*)(CARRY + (size_t)unit * D + ch);
        float Hc[4] = {hc.x, hc.y, hc.z, hc.w};
#pragma unroll 5
        for (int i = 0; i < CHROWS; ++i) {
            const size_t off = (r0 + i) * D + ch;
            const h16x4 la = *(const h16x4*)(LA + off), vv = *(const h16x4*)(V + off);
            const u32x2 ug = *(const u32x2*)(UG + off), gr = *(const u32x2*)(GR + off);
            const float ugf[4] = {bf_lo(ug.x), bf_hi(ug.x), bf_lo(ug.y), bf_hi(ug.y)}, grf[4] = {bf_lo(gr.x), bf_hi(gr.x), bf_lo(gr.y), bf_hi(gr.y)};
            float y[4];
#pragma unroll
            for (int k = 0; k < 4; ++k) { const float lr = (float)la[k]; const float ak = __expf(lr);
                Hc[k] = ak * Hc[k] + __builtin_amdgcn_sqrtf(nexpm1_fast(2.0f * lr)) * (float)vv[k];
                y[k] = Hc[k] * gelu_fast(ugf[k]) * sigm_fast(grf[k]); }
            if (c * CHROWS + i < PADF) { y[0] = 0.f; y[1] = 0.f; y[2] = 0.f; y[3] = 0.f; }
            *(u32x2*)(Y + off) = (u32x2){cvt_pk_bf16(y[0], y[1]), cvt_pk_bf16(y[2], y[3])};
        }
    }
}


constexpr int IDX_KBUF = 65536, IDX_TAB = 131072, IDX_CAP = 16, IDX_DB = 9, IDX_OVF = 2048, IDX_TMP = 1024;
__device__ __forceinline__ unsigned mono_key(float s) { const unsigned v = __float_as_uint(s); return v ^ ((unsigned)((int)v >> 31) | 0x80000000u); }
__device__ __forceinline__ unsigned qb_bin(float v) { const unsigned bits = __float_as_uint(v); int f = (int)((bits >> 21) & 0x3ffu) - 444; f = f < 0 ? 0 : (f > 255 ? 255 : f); return (bits >> 31) ? (unsigned)(255 - f) : (unsigned)(256 + f); }
__device__ __forceinline__ float qb_edge(int f) { return f <= 0 ? 0.f : __uint_as_float((unsigned)(f + 444) << 21); }
__device__ __forceinline__ float qb_lo(unsigned b) { return b >= 256u ? qb_edge((int)b - 256) : -qb_edge(256 - (int)b); }
__device__ __forceinline__ float qb_hi(unsigned b) { return b >= 256u ? qb_edge((int)b - 255) : -qb_edge(255 - (int)b); }
__device__ __forceinline__ float inv_mono_key(unsigned k) { return __uint_as_float((k & 0x80000000u) ? (k ^ 0x80000000u) : ~k); }
__device__ __forceinline__ float bin_threshold(float target, float wsc, float wof) {
    unsigned k = mono_key((target - wof) / wsc);
    for (int i = 0; i < 64 && fmaf(inv_mono_key(k - 1u), wsc, wof) >= target; ++i) --k;
    for (int i = 0; i < 64 && !(fmaf(inv_mono_key(k), wsc, wof) >= target); ++i) ++k;
    return inv_mono_key(k);
}
__device__ __forceinline__ unsigned long long* mask_chunk(unsigned long long* MASK, int b, int qblk, int j) { return MASK + ((size_t)b * MASK_CHUNKS_PER_BATCH + 2 * qblk * (qblk + 1) + j) * 256; }

constexpr int IDX_WB = 256;
template <int MODE>
__device__ __forceinline__ void idx_sweep(LAS unsigned char* lds, const bf16_t* KIb, const bf16x8 (&qf)[8][2], const bf16x8 (&qs)[2][2], const float (&cs)[8], const int u, const int tid, const unsigned pfx, const int a_q, const unsigned Wq, unsigned long long* mrow, const int stride, const int shift, const float wlo, const float whi, const float wsc, const float wof, unsigned long long* gbuf) {
    const int lane = tid & 63, wid = __builtin_amdgcn_readfirstlane(tid >> 6), q16 = lane & 15, g = lane >> 4, qg = wid & 3, ksp = wid >> 2;
    const int nsteps = (u >> 2) + 1;
    const bf16_t* gsrc = KIb + (size_t)(tid >> 3) * IDIM + (((tid & 7) ^ ((tid >> 4) & 7)) << 3);
    LAS unsigned char* kb = lds + IDX_KBUF;
    const unsigned dma_off = (unsigned)wid * 1024u;
    const int sw = (q16 >> 1) & 7;
    const int kaddr0 = q16 * 128 + ((g ^ sw) << 4), kaddr1 = q16 * 128 + (((g + 4) ^ sw) << 4);
    LAS unsigned* hist = (LAS unsigned*)lds;
    const int qrow = 16 * qg + q16, hrow_ = qrow * 256, hx = qrow & 31;
    unsigned ccount = 0u; const int csub = qrow * 8 + ksp * 4 + g;
    unsigned above = 0u;
    float f_lo = 0.f, f_hi = 0.f;
    if (MODE == 4) { if (pfx == 0xFFFFFFFFu) { f_hi = -3.402823466e38f; f_lo = f_hi; } else { f_lo = inv_mono_key(pfx << shift); f_hi = inv_mono_key((pfx + 1u) << shift); } }
    float t_sel = -3.402823466e38f, t_cand = -3.402823466e38f;
    if (MODE == 7 && wsc > 0.f) { t_cand = bin_threshold((float)((int)pfx + 1), wsc, wof); t_sel = bin_threshold((float)((int)pfx + 2), wsc, wof); }
#pragma unroll
    for (int i = 0; i < 4; ++i) __builtin_amdgcn_global_load_lds((const unsigned*)(gsrc + (size_t)(64 * i) * IDIM), (LAS unsigned*)(kb + i * 8192 + dma_off), 16, 0, 0);
    asm volatile("s_waitcnt vmcnt(0)" ::: "memory");
    __syncthreads();
    for (int s = 0, it = 0; s < nsteps; s += stride, ++it) {
        const bool more = s + stride < nsteps;
        if (more) {
#pragma unroll
            for (int i = 0; i < 4; ++i) __builtin_amdgcn_global_load_lds((const unsigned*)(gsrc + (size_t)(256 * (s + stride) + 64 * i) * IDIM), (LAS unsigned*)(kb + ((it + 1) & 1) * 32768 + i * 8192 + dma_off), 16, 0, 0); }
#pragma unroll
        for (int tt = 0; tt < 2; ++tt) {
            const int t = 4 * s + 2 * ksp + tt;
            const LAS unsigned char* kt = kb + (it & 1) * 32768 + (2 * ksp + tt) * 8192;
            if (t >= 3 && t <= u) {
                const bool edge = (t == u) || (t == 3);
                f32x4 sc[4];
                {
                    bf16x8 kf[4][2];
#pragma unroll
                    for (int bk = 0; bk < 4; ++bk) { kf[bk][0] = *(const LAS bf16x8*)(kt + kaddr0 + bk * 2048); kf[bk][1] = *(const LAS bf16x8*)(kt + kaddr1 + bk * 2048); }
                    const f32x4 z4 = {0.f, 0.f, 0.f, 0.f};
                    f32x4 a_cur = __builtin_amdgcn_mfma_f32_16x16x32_bf16(kf[0][0], qs[0][0], z4, 0, 0, 0), a_done = z4, sv = z4;
#pragma unroll
                    for (int j = 0; j <= 36; ++j) {
                        f32x4 a_nxt = z4, b_ = z4;
                        if (j < 36) {
                            if (j + 1 < 36) { const int bk1 = (j + 1) / 9, j1 = (j + 1) % 9; a_nxt = __builtin_amdgcn_mfma_f32_16x16x32_bf16(kf[bk1][0], j1 == 0 ? qs[0][0] : qf[j1 == 0 ? 0 : j1 - 1][0], z4, 0, 0, 0); }
                            const int bk = j / 9, jj = j % 9;
                            b_ = __builtin_amdgcn_mfma_f32_16x16x32_bf16(kf[bk][1], jj == 0 ? qs[0][1] : qf[jj == 0 ? 0 : jj - 1][1], a_cur, 0, 0, 0);
                        }
                        __builtin_amdgcn_sched_barrier(0);
                        if (j >= 1) { const int bkp = (j - 1) / 9, jp = (j - 1) % 9;
                            if (jp == 0) sv = a_done;
                            else {
#pragma unroll
                                for (int r = 0; r < 4; ++r) { sv[r] = fmaf(__builtin_fabsf(a_done[r]), cs[jp - 1], sv[r]); asm volatile("" : "+v"(sv[r])); }
                            }
                            if (jp == 8) sc[bkp] = sv; }
                        __builtin_amdgcn_sched_barrier(0);
                        a_done = b_; a_cur = a_nxt;
                    }
                }
                if (edge) {
                    const int dq = a_q - 64 * t - 4 * g;
#pragma unroll
                    for (int bk = 0; bk < 4; ++bk)
#pragma unroll
                        for (int r = 0; r < 4; ++r) { if ((unsigned)(dq - (16 * bk + r)) >= Wq) sc[bk][r] = -__builtin_inff(); }
                }
                if (MODE == 6) {
                    const unsigned rb = (unsigned)(uintptr_t)(hist + hrow_) - 4u; unsigned one_ = 1u; asm volatile("" : "+v"(one_));
#pragma unroll
                    for (int bk = 0; bk < 4; ++bk)
#pragma unroll
                        for (int r = 0; r < 4; ++r) { int t = (int)fmaf(sc[bk][r], wsc, wof); t = t < IDX_WB ? t : IDX_WB;
                            const unsigned addr = ((unsigned)t << 2) + rb;
                            unsigned long long sv_;
                            asm volatile("v_cmp_lt_i32 vcc, 0, %2\n\ts_and_saveexec_b64 %0, vcc\n\tds_add_u32 %1, %3\n\ts_mov_b64 exec, %0" : "=&s"(sv_) : "v"(addr), "v"(t), "v"(one_) : "vcc", "memory");
                        }
                } else if (MODE == 5) {
#pragma unroll
                    for (int bk = 0; bk < 4; ++bk)
#pragma unroll
                        for (int r = 0; r < 4; ++r) { const unsigned bin = qb_bin(sc[bk][r]);
                            __hip_atomic_fetch_add(hist + hrow_ + ((bin >> 1) ^ hx), (bin & 1u) ? 65536u : 1u, __ATOMIC_RELAXED, __HIP_MEMORY_SCOPE_WORKGROUP); }
                } else if (MODE < 3) {
#pragma unroll
                    for (int bk = 0; bk < 4; ++bk)
#pragma unroll
                        for (int r = 0; r < 4; ++r) {
                            const unsigned key = mono_key(sc[bk][r]);
                            const bool match = (MODE == 0) ? true : ((key >> ((32 - IDX_DB * MODE) & 31)) == pfx);
                            if (match) { const unsigned bin = (key >> (32 - IDX_DB - IDX_DB * MODE)) & 511u;
                                __hip_atomic_fetch_add(hist + hrow_ + ((bin >> 1) ^ hx), (bin & 1u) ? 65536u : 1u, __ATOMIC_RELAXED, __HIP_MEMORY_SCOPE_WORKGROUP); }
                        }
                } else {
                    unsigned wlo_ = 0u, whi_ = 0u;
                    if (MODE == 3) {
#pragma unroll
                        for (int bk = 0; bk < 4; ++bk)
#pragma unroll
                            for (int r = 0; r < 4; ++r) { if (mono_key(sc[bk][r]) >= pfx) { if (bk < 2) wlo_ |= 1u << (16 * bk + r); else whi_ |= 1u << (16 * (bk - 2) + r); } }
                    } else {
                        unsigned cm = 0u;
#pragma unroll
                        for (int bk = 0; bk < 4; ++bk)
#pragma unroll
                            for (int r = 0; r < 4; ++r) { const float v = sc[bk][r];
                                if (MODE == 7) continue;
                                const bool selv = v >= f_hi, candv = !selv && v >= f_lo;
                                if (selv) { if (bk < 2) wlo_ |= 1u << (16 * bk + r); else whi_ |= 1u << (16 * (bk - 2) + r); }
                                else if (candv) cm |= 1u << (4 * bk + r); }
                        if (MODE == 7) {
                            unsigned selw = 0u; const int p1 = (int)pfx + 1;
#pragma unroll
                            for (int e = 15; e >= 0; --e)
                                asm volatile("v_cmp_ge_f32 vcc, %2, %3\n\tv_addc_co_u32 %0, vcc, %0, %0, vcc\n\tv_cmp_ge_f32 vcc, %2, %4\n\tv_addc_co_u32 %1, vcc, %1, %1, vcc" : "+v"(selw), "+v"(cm) : "v"(sc[e >> 2][e & 3]), "v"(t_sel), "v"(t_cand) : "vcc");
                            cm &= ~selw; (void)p1;
                            wlo_ = (selw & 0xFu) | ((selw & 0xF0u) << 12); whi_ = ((selw >> 8) & 0xFu) | ((selw & 0xF000u) << 4);
                        }
                        if (__any(cm != 0u)) {
                            LAS unsigned long long* clist = (LAS unsigned long long*)lds + (size_t)csub * IDX_CAP;
#pragma unroll
                            for (int bk = 0; bk < 4; ++bk) { if (__any((cm >> (4 * bk)) & 15u)) {
#pragma unroll
                                for (int r = 0; r < 4; ++r) { if (cm & (1u << (4 * bk + r))) {
                                    const unsigned long long e_ = ((unsigned long long)__float_as_uint(sc[bk][r]) << 32) | (unsigned)(64 * t + 16 * bk + 4 * g + r);
                                    if (ccount < (unsigned)IDX_CAP) clist[ccount] = e_;
                                    else { const unsigned sl = __hip_atomic_fetch_add((LAS unsigned*)(lds + IDX_TAB) + 195, 1u, __ATOMIC_RELAXED, __HIP_MEMORY_SCOPE_WORKGROUP);
                                        if (sl < (unsigned)IDX_OVF) { gbuf[2 * sl] = (unsigned long long)qrow; gbuf[2 * sl + 1] = e_; } }
                                    ++ccount; } } } }
                        }
                    }
                    wlo_ <<= 4 * g; whi_ <<= 4 * g;
                    wlo_ |= __shfl_xor(wlo_, 16); whi_ |= __shfl_xor(whi_, 16); wlo_ |= __shfl_xor(wlo_, 32); whi_ |= __shfl_xor(whi_, 32);
                    if (g == 0) mrow[(size_t)t * 256] = ((unsigned long long)whi_ << 32) | wlo_;
                }
            } else if (MODE >= 3 && t > u) {
                if (g == 0) mrow[(size_t)t * 256] = 0ull;
            }
        }
        asm volatile("s_waitcnt vmcnt(0)" ::: "memory");
        __syncthreads();
    }
    if (MODE == 4 || MODE == 7) ((LAS unsigned*)(lds + IDX_TAB) + 256)[csub] = ccount;
    if (MODE == 6) asm volatile("s_waitcnt lgkmcnt(0)" ::: "memory");
}

constexpr unsigned IDX_ZOOM = 900u;
template <int FM>
__device__ __forceinline__ void idx_find(LAS unsigned char* lds, int tid, int u, bool exact) {
    const int lane = tid & 63, wid = __builtin_amdgcn_readfirstlane(tid >> 6);
    LAS unsigned* hist = (LAS unsigned*)lds; LAS unsigned* ptab = (LAS unsigned*)(lds + IDX_TAB); LAS unsigned* rtab = ptab + 64; LAS unsigned* atab = ptab + 128; LAS unsigned* ftab = ptab + 192; LAS float* wtab = (LAS float*)(ptab + 768);
    for (int i = 0; i < 8; ++i) {
        const int q = 8 * wid + i;
        unsigned c[8]; unsigned T = 0u;
#pragma unroll
        for (int k = 0; k < 4; ++k) { LAS unsigned* pp = hist + q * 256 + ((4 * lane + k) ^ (FM == 2 ? 0 : (q & 31)));     const unsigned d = *pp; *pp = 0u; c[2 * k] = FM == 2 ? d : (d & 0xffffu); c[2 * k + 1] = FM == 2 ? 0u : (d >> 16); T += c[2 * k] + c[2 * k + 1]; }
        unsigned x = T;
#pragma unroll
        for (int off = 1; off < 64; off <<= 1) { const unsigned y = __shfl_down(x, off); if (lane + off < 64) x += y; }
        const unsigned total = (unsigned)__shfl((int)x, 0);
        const int Wq = 64 * u + q - PADF + 1;
        if (Wq <= 256) { if (FM == 1 && lane == 0) { wtab[q] = -3.0e38f; wtab[64 + q] = -3.0e38f; wtab[128 + q] = 0.f; wtab[192 + q] = 1000.f; } continue; }
        unsigned rank = 256u, rank2 = 256u;
        LAS unsigned* stab = (LAS unsigned*)(lds + MISC_OFF + 2048);
        if (FM == 1 && !exact) { const unsigned rs = (unsigned)((256ull * total + (unsigned)Wq / 2) / (unsigned)Wq); if (lane == 0) stab[q] = rs;
            rank = rs / 2 > 3u ? rs / 2 - 3u : 1u; rank2 = 2u * rs + 8u; if (rank2 > total) rank2 = total; if (rank2 < 1u) rank2 = 1u; }
        if (FM == 3) {
            const unsigned rs = stab[q], ab = atab[q]; const unsigned r1 = rs / 2 > 3u ? rs / 2 - 3u : 1u, r2 = 2u * rs + 8u;
            rank = r1 > ab ? r1 - ab : 0u; rank2 = r2 > ab ? r2 - ab : 1u; if (rank2 > total) rank2 = total; if (rank2 < 1u) rank2 = 1u; }
        if (FM == 2) { if (total < 256u) { if (lane == 0) ftab[1] = 1u; continue; } }
        const unsigned ab0 = x - T;
        unsigned ab = ab0; int sel = -1; unsigned above = 0u, cb = 0u;
#pragma unroll
        for (int k = 7; k >= 0; --k) { if (sel < 0 && ab < rank && rank <= ab + c[k]) { sel = k; above = ab; cb = c[k]; } ab += c[k]; }
        const unsigned long long bal = __ballot(sel >= 0);
        unsigned bstar = 0u, nrank = rank, cbin = 0u;
        if (bal) { const int L = __ffsll((long long)bal) - 1; bstar = 8u * (unsigned)L + (unsigned)__shfl(sel, L); nrank = rank - (unsigned)__shfl((int)above, L); cbin = (unsigned)__shfl((int)cb, L); }
        if (FM == 2) bstar >>= 1;
        if (FM == 2 && (!bal || bstar == (unsigned)IDX_WB - 1u)) { if (lane == 0) ftab[1] = 1u; continue; }
        if (FM == 1 || FM == 3) {
            ab = ab0; int sel2 = -1;
#pragma unroll
            for (int k = 7; k >= 0; --k) { if (sel2 < 0 && ab < rank2 && rank2 <= ab + c[k]) sel2 = k; ab += c[k]; }
            const unsigned long long bal2 = __ballot(sel2 >= 0);
            unsigned bbot = bstar; if (bal2) { const int L2 = __ffsll((long long)bal2) - 1; bbot = 8u * (unsigned)L2 + (unsigned)__shfl(sel2, L2); }
            if (lane == 0) {
                if (FM == 1) { if (bbot > bstar) bbot = bstar;
                    const float lo = qb_lo(bbot), hi = qb_hi(bstar), scale = (float)(IDX_WB - 1) / (hi - lo);
                    wtab[q] = lo; wtab[64 + q] = hi; wtab[128 + q] = scale; wtab[192 + q] = -lo * scale + 1.0f; }
                else {
                    const float lo0 = wtab[q], hi0 = wtab[64 + q], w = 1.0f / wtab[128 + q];
                    unsigned btop = (rank == 0u || !bal) ? 511u : bstar; if (bbot > btop) bbot = btop;
                    float lo = lo0 + (float)bbot * w, hi = (btop >= 511u) ? hi0 : lo0 + (float)(btop + 1u) * w;
                    if (!(hi > lo)) { lo = lo0; hi = hi0; }
                    const float scale = 512.0f / (hi - lo);
                    wtab[q] = lo; wtab[64 + q] = hi; wtab[128 + q] = scale; wtab[192 + q] = -lo * scale + 1.0f; }
            }
        }
        if (FM == 2 && lane == 0) {
            ptab[q] = bstar; rtab[q] = nrank;
            LAS float* ztab = (LAS float*)(lds + MISC_OFF + 1024);
            ztab[128 + q] = 0.f;
            if (cbin > 8u) {
                const float lo = wtab[q], sc = wtab[128 + q], w = 1.0f / sc;
                const float nlo = lo + ((float)bstar - 1.0f) * w, nhi = lo + ((float)bstar + 2.0f) * w;
                if (nhi > nlo) { const float ns = (float)(IDX_WB - 1) / (nhi - nlo);
                    if (cbin > IDX_ZOOM) { wtab[q] = nlo; wtab[64 + q] = nhi; wtab[128 + q] = ns; wtab[192 + q] = -nlo * ns + 1.0f; ftab[2] = 1u; }
                    else { ztab[q] = nlo; ztab[64 + q] = nhi; ztab[128 + q] = ns; ztab[192 + q] = -nlo * ns + 1.0f; } }
            }
        }
    }
}

__device__ __forceinline__ void idx_unit(LAS unsigned char* lds, const bf16_t* QI, const bf16_t* KI, const float* WI, unsigned long long* MASK, const int b, const int u, const int tid) {
    const int lane = tid & 63, wid = __builtin_amdgcn_readfirstlane(tid >> 6), q16 = lane & 15, g = lane >> 4, qg = wid & 3;
    const int a_q = 64 * u + 16 * qg + q16; const size_t row = (size_t)b * RA + a_q;
    const unsigned Wq = a_q >= PADF ? (unsigned)(a_q - PADF + 1) : 0u;
    LAS unsigned* ptab = (LAS unsigned*)(lds + IDX_TAB); LAS unsigned* rtab = ptab + 64;
    for (int i = tid; i < 16384; i += NTHREADS) ((LAS unsigned*)lds)[i] = 0u;
    if (tid < 64) { ptab[tid] = 0u; rtab[tid] = 256u; }
    bf16x8 qf[8][2]; bf16x8 qs[2][2]; float cs[8];
    float qsum[2][8];
#pragma unroll
    for (int ks = 0; ks < 2; ++ks)
#pragma unroll
        for (int j = 0; j < 8; ++j) qsum[ks][j] = 0.f;
#pragma unroll
    for (int h = 0; h < 8; ++h) {
        const float w = WI[row * 8 + h];
        cs[h] = w > 0.f ? 1.f : (w < 0.f ? -1.f : 0.f);
#pragma unroll
        for (int ks = 0; ks < 2; ++ks) {
            const u32x4 raw = *(const u32x4*)(QI + row * 512 + h * 64 + ks * 32 + g * 8);
            u32x4 o; o.x = cvt_pk_bf16(bf_lo(raw.x) * w, bf_hi(raw.x) * w); o.y = cvt_pk_bf16(bf_lo(raw.y) * w, bf_hi(raw.y) * w);
            o.z = cvt_pk_bf16(bf_lo(raw.z) * w, bf_hi(raw.z) * w); o.w = cvt_pk_bf16(bf_lo(raw.w) * w, bf_hi(raw.w) * w);
            qf[h][ks] = *reinterpret_cast<bf16x8*>(&o);
            qsum[ks][0] += bf_lo(o.x); qsum[ks][1] += bf_hi(o.x); qsum[ks][2] += bf_lo(o.y); qsum[ks][3] += bf_hi(o.y);
            qsum[ks][4] += bf_lo(o.z); qsum[ks][5] += bf_hi(o.z); qsum[ks][6] += bf_lo(o.w); qsum[ks][7] += bf_hi(o.w);
        }
    }
#pragma unroll
    for (int ks = 0; ks < 2; ++ks) {
        u32x4 hi, lo;
        { const unsigned hw = cvt_pk_bf16(qsum[ks][0], qsum[ks][1]); hi.x = hw; lo.x = cvt_pk_bf16(qsum[ks][0] - bf_lo(hw), qsum[ks][1] - bf_hi(hw)); }
        { const unsigned hw = cvt_pk_bf16(qsum[ks][2], qsum[ks][3]); hi.y = hw; lo.y = cvt_pk_bf16(qsum[ks][2] - bf_lo(hw), qsum[ks][3] - bf_hi(hw)); }
        { const unsigned hw = cvt_pk_bf16(qsum[ks][4], qsum[ks][5]); hi.z = hw; lo.z = cvt_pk_bf16(qsum[ks][4] - bf_lo(hw), qsum[ks][5] - bf_hi(hw)); }
        { const unsigned hw = cvt_pk_bf16(qsum[ks][6], qsum[ks][7]); hi.w = hw; lo.w = cvt_pk_bf16(qsum[ks][6] - bf_lo(hw), qsum[ks][7] - bf_hi(hw)); }
        qs[0][ks] = *reinterpret_cast<bf16x8*>(&hi); qs[1][ks] = *reinterpret_cast<bf16x8*>(&lo);
    }
    const bf16_t* KIb = KI + (size_t)b * RA * IDIM;
    unsigned long long* mrow = mask_chunk(MASK, b, u >> 2, 0) + (size_t)(64 * (u & 3) + 16 * qg + q16);
    __syncthreads();
    LAS unsigned* ccnt = ptab + 256; LAS unsigned* oflag = ptab + 192; LAS unsigned* wfail = ptab + 193; LAS unsigned* zflag = ptab + 194; LAS unsigned* atab = ptab + 128; LAS float* wtab = (LAS float*)(ptab + 768);
    const int u0 = u; const bf16_t* KIb0 = KIb;
    unsigned long long* gbuf = (unsigned long long*)((unsigned char*)MASK - WS_A0 + WS_AGG) + (size_t)blockIdx.x * (2 * IDX_OVF);
    LAS unsigned* ovfc = ptab + 195;
    int stage = (u0 >= 32) ? 0 : 1, zooms = 0; bool have_window = false;
    const int sstride = (u0 >= 96) ? 8 : 4;
    for (;;) {
        int u = u0; GAS const bf16_t* KIbg_ = (GAS const bf16_t*)KIb0; asm volatile("" : "+s"(u), "+s"(KIbg_)); const bf16_t* KIb = (const bf16_t*)KIbg_;
        if (tid < 64) atab[tid] = 0u; if (tid == 64) { *oflag = 0u; *wfail = 0u; *zflag = 0u; *ovfc = 0u; }
        __syncthreads();
        int pass = have_window ? 2 : 0;
        if (pass == 0) {
            idx_sweep<5>(lds, KIb, qf, qs, cs, u, tid, 0u, a_q, Wq, mrow, stage == 0 ? sstride : 1, 0, 0.f, 0.f, 0.f, 0.f, gbuf);
            idx_find<1>(lds, tid, u, stage != 0); __syncthreads();
            pass = 2;
        }
        float wlo, whi, wsc, wof;
        for (;;) {
            wlo = wtab[16 * qg + q16]; whi = wtab[64 + 16 * qg + q16]; wsc = wtab[128 + 16 * qg + q16]; wof = wtab[192 + 16 * qg + q16];
            idx_sweep<6>(lds, KIb, qf, qs, cs, u, tid, 0u, a_q, Wq, mrow, pass == 1 ? 4 : 1, 0, wlo, whi, wsc, wof, gbuf);
            __syncthreads();
            if (pass == 2) break;
            idx_find<3>(lds, tid, u, false); __syncthreads();
            if (tid < 64) atab[tid] = 0u;
            __syncthreads();
            pass = 2;
        }
        idx_find<2>(lds, tid, u, false); __syncthreads();
        if (*wfail) { if (stage == 0) { stage = 1; have_window = false; __syncthreads(); continue; } }
        else if (*zflag && zooms < 3) { ++zooms; have_window = true; __syncthreads(); continue; }
        idx_sweep<7>(lds, KIb, qf, qs, cs, u, tid, ptab[16 * qg + q16], a_q, Wq, mrow, 1, 0, wlo, whi, wsc, wof, gbuf);
        __syncthreads();
        {
            LAS unsigned long long* clist = (LAS unsigned long long*)lds;
            LAS unsigned long long* tmpw = (LAS unsigned long long*)(lds + IDX_KBUF) + wid * IDX_TMP;
            const unsigned novf = *ovfc < (unsigned)IDX_OVF ? *ovfc : (unsigned)IDX_OVF;
            for (int i = 0; i < 8; ++i) {
                const int q = 8 * wid + i; const unsigned need = rtab[q];
                if (64 * u + q - PADF + 1 <= 256) continue;
                const int sub = q * 8 + (lane >> 3), slot = lane & 7; unsigned c = ccnt[sub]; c = c > (unsigned)IDX_CAP ? (unsigned)IDX_CAP : c;
                const bool v0 = (unsigned)slot < c, v1 = (unsigned)(slot + 8) < c;
                const unsigned long long e0 = v0 ? clist[sub * IDX_CAP + slot] : 0ull, e1 = v1 ? clist[sub * IDX_CAP + slot + 8] : 0ull;
                const unsigned long long bal0 = __ballot(v0), bal1 = __ballot(v1); const int n0 = __popcll(bal0); int n = n0 + __popcll(bal1);
                if (v0) tmpw[(int)__builtin_amdgcn_mbcnt_hi((unsigned)(bal0 >> 32), __builtin_amdgcn_mbcnt_lo((unsigned)bal0, 0u))] = e0;
                if (v1) tmpw[n0 + (int)__builtin_amdgcn_mbcnt_hi((unsigned)(bal1 >> 32), __builtin_amdgcn_mbcnt_lo((unsigned)bal1, 0u))] = e1;
                for (unsigned j0 = 0; j0 < novf; j0 += 64) {
                    const unsigned j = j0 + lane; const bool vq = j < novf && gbuf[2 * j] == (unsigned long long)q;
                    const unsigned long long bq = __ballot(vq);
                    if (vq) { const int idx = n + (int)__builtin_amdgcn_mbcnt_hi((unsigned)(bq >> 32), __builtin_amdgcn_mbcnt_lo((unsigned)bq, 0u)); if (idx < IDX_TMP) tmpw[idx] = gbuf[2 * j + 1]; }
                    n += __popcll(bq);
                }
                if (n > IDX_TMP) n = IDX_TMP;
                if (n == 0) continue;
                asm volatile("s_waitcnt lgkmcnt(0)" ::: "memory");
                for (int c0 = 0; c0 < n; c0 += 64) {
                    const bool va = c0 + lane < n; const unsigned long long ea = va ? tmpw[c0 + lane] : 0ull;
                    const float sa = __uint_as_float((unsigned)(ea >> 32)); const unsigned pa = (unsigned)ea;
                    unsigned ra = 0u;
                    for (int j = 0; j < n; ++j) { const unsigned long long ej = tmpw[j]; const float sj = __uint_as_float((unsigned)(ej >> 32)); const unsigned pj = (unsigned)ej; ra += (sj > sa || (sj == sa && pj < pa)) ? 1u : 0u; }
                    if (va && ra < need) atomicOr(mask_chunk(MASK, b, u >> 2, (int)(pa >> 6)) + (64 * (u & 3) + q), 1ull << (pa & 63u));
                }
                asm volatile("s_waitcnt lgkmcnt(0)" ::: "memory");
            }
        }
        __syncthreads();
        break;
    }
}
__device__ __forceinline__ int queue_pop(unsigned* ctr, volatile LAS unsigned* slot, int tid) {
    if (tid == 0) *slot = __hip_atomic_fetch_add(ctr, 1u, __ATOMIC_RELAXED, __HIP_MEMORY_SCOPE_AGENT);
    __syncthreads();
    const int v = (int)*slot;
    __syncthreads();
    return v;
}
__device__ __forceinline__ void phase_indexer(LAS unsigned char* lds, const bf16_t* QI, const bf16_t* KI, const float* WI, unsigned long long* MASK, unsigned* ctr, const int wid0) {
    constexpr int NITEM = 2 * 257;
    volatile LAS unsigned* slot = (volatile LAS unsigned*)(lds + MISC_OFF) + 16;
    for (;;) {
        const int tid = opaque_tid(wid0);
        const int i = queue_pop(ctr, slot, tid);
        if (i >= NITEM) break;
        idx_unit(lds, QI, KI, WI, MASK, i & 1, 259 - (i >> 1), opaque_tid(wid0));
        __syncthreads();
    }
}


namespace att {
constexpr int NW = 8, QBLK = 32, KVBLK = 64, QB = NW * QBLK, RS = 1024;
constexpr int SHM_V = KVBLK * HD * 2, SHM_K = KVBLK * HD * 2;
constexpr int WS_OFF = 2 * SHM_V + 2 * SHM_K, LUT_OFF = WS_OFF + NW * 64 * 4, EPI_OFF = 69632;
constexpr float SCALE = 0.08838834764831845f;
constexpr float THR = 8.f;
#define KSWZ(row, colB) ((row) * 256 + ((colB) ^ (((row) & 7) << 4)))
#define SBAR() __builtin_amdgcn_sched_barrier(0)
__device__ __forceinline__ int v_st(int k, int c) { const int kk = (k & ~0xC) | ((k & 4) << 1) | ((k & 8) >> 1); return ((kk >> 3) * 4 + (c >> 5)) * 512 + ((kk & 7) * 32 + (c & 31)) * 2; }
__device__ __forceinline__ int v_rd_base(int lane) { return ((lane & 3) << 3) | (((lane >> 2) & 3) << 6) | (((lane >> 4) & 1) << 5) | (((lane >> 5) & 1) << 8); }
constexpr int v_rd_off(int d0, int ks, int half) { return d0 * 512 + ks * 4096 + half * 2048; }
__device__ __forceinline__ int crow(int r, int hi) { return (r & 3) + 8 * (r >> 2) + 4 * hi; }
__device__ __forceinline__ bf16x8 load8(const bf16_t* p) { return *reinterpret_cast<const bf16x8*>(p); }

__device__ __forceinline__ void mask_tile(f32x16& p0, f32x16& p1, unsigned long long mw, int hi) {
    const unsigned long long sh = mw >> (4 * hi);
    const int lo = (int)(unsigned)sh, hh = (int)(unsigned)(sh >> 32);
    const int NEG = (int)0xff800000u;
#pragma unroll
    for (int r = 0; r < 16; ++r) {
        const int c = (r & 3) + 8 * (r >> 2);
        const int m0 = __builtin_amdgcn_sbfe(lo, c, 1), m1 = __builtin_amdgcn_sbfe(hh, c, 1);
        float q0 = p0[r], q1 = p1[r];
        asm("v_bfi_b32 %0, %1, %0, %2" : "+v"(q0) : "v"(m0), "s"(NEG));
        asm("v_bfi_b32 %0, %1, %0, %2" : "+v"(q1) : "v"(m1), "s"(NEG));
        p0[r] = q0; p1[r] = q1;
    }
}
__device__ __forceinline__ void bias_tile(f32x16& p0, f32x16& p1, int dq, const float* lut) {
#pragma unroll
    for (int r = 0; r < 16; ++r) {
        const int c = (r & 3) + 8 * (r >> 2);
        const unsigned d0 = (unsigned)(dq - c), d1 = (unsigned)(dq - c - 32);
        p0[r] += lut[d0 < 127u ? d0 : 127u]; p1[r] += lut[d1 < 127u ? d1 : 127u];
    }
}
__device__ __forceinline__ float max3_s(float a, float b, float c) { float d; asm("v_max3_f32 %0, %1, %2, %3" : "=v"(d) : "v"(a), "v"(b), "v"(c)); return d; }
__device__ __forceinline__ float max2_s(float a, float b) { float d; asm("v_max_f32 %0, %1, %2" : "=v"(d) : "v"(a), "v"(b)); return d; }
__device__ __forceinline__ float max2_s_pl(float a, float b) { float d; asm("v_max_f32 %0, %1, %2\n\ts_nop 1" : "=v"(d) : "v"(a), "v"(b)); return d; }
constexpr float THRL = THR * 1.4426950408889634f;
__device__ __forceinline__ void partialSM(f32x16& p0, f32x16& p1, float& m_ref, f32x16& minit, float& alpha) {
    float pmax = max3_s(p0[0], p0[1], p0[2]);
#pragma unroll
    for (int r = 3; r + 1 < 16; r += 2) pmax = max3_s(pmax, p0[r], p0[r + 1]);
    pmax = max3_s(pmax, p0[15], p1[0]);
#pragma unroll
    for (int r = 1; r + 1 < 16; r += 2) pmax = max3_s(pmax, p1[r], p1[r + 1]);
    pmax = max2_s_pl(pmax, p1[15]);
    { auto rr = __builtin_amdgcn_permlane32_swap(__float_as_uint(pmax), __float_as_uint(pmax), false, false);
      pmax = max2_s(__uint_as_float(rr[0]), __uint_as_float(rr[1])); }
    alpha = 1.f;
    if (!__builtin_expect(__all(pmax <= THRL), 1)) {
        const float d = fmaxf(pmax, 0.f);
        alpha = __builtin_amdgcn_exp2f(-d); m_ref += d;
#pragma unroll
        for (int r = 0; r < 16; ++r) { p0[r] -= d; p1[r] -= d; minit[r] = -m_ref; }
    }
#pragma unroll
    for (int r = 0; r < 16; ++r) p0[r] = __builtin_amdgcn_exp2f(p0[r]);
}
__device__ __forceinline__ void partialSM_post(f32x16& p0, f32x16& p1, float pmax, float& m_ref, f32x16& minit, float& alpha) {
    asm volatile("s_nop 1" ::: );
    { auto rr = __builtin_amdgcn_permlane32_swap(__float_as_uint(pmax), __float_as_uint(pmax), false, false);
      pmax = max2_s(__uint_as_float(rr[0]), __uint_as_float(rr[1])); }
    alpha = 1.f;
    if (!__builtin_expect(__all(pmax <= THRL), 1)) {
        const float d = fmaxf(pmax, 0.f);
        alpha = __builtin_amdgcn_exp2f(-d); m_ref += d;
#pragma unroll
        for (int r = 0; r < 16; ++r) { p0[r] -= d; p1[r] -= d; minit[r] = -m_ref; }
    }
#pragma unroll
    for (int r = 0; r < 16; ++r) p0[r] = __builtin_amdgcn_exp2f(p0[r]);
}
__device__ __forceinline__ void finishSM(f32x16& p0, f32x16& p1, float alpha, float& l_reg, bf16x8& pa0, bf16x8& pa1, bf16x8& pa2, bf16x8& pa3) {
#pragma unroll
    for (int r = 0; r < 16; ++r) p1[r] = __builtin_amdgcn_exp2f(p1[r]);
    float ps = 0;
#pragma unroll
    for (int r = 0; r < 16; ++r) ps += p0[r];
#pragma unroll
    for (int r = 0; r < 16; ++r) ps += p1[r];
    { auto rr = __builtin_amdgcn_permlane32_swap(__float_as_uint(ps), __float_as_uint(ps), false, false);
      ps = __uint_as_float(rr[0]) + __uint_as_float(rr[1]); }
    l_reg = l_reg * alpha + ps;
#define PK4(P, B_, OUT) do { unsigned a0 = cvt_pk_bf16(P[B_+0], P[B_+1]), a1 = cvt_pk_bf16(P[B_+2], P[B_+3]);                          \
        unsigned b0 = cvt_pk_bf16(P[B_+4], P[B_+5]), b1 = cvt_pk_bf16(P[B_+6], P[B_+7]);                                             \
        auto r0 = __builtin_amdgcn_permlane32_swap(a0, b0, false, false); auto r1 = __builtin_amdgcn_permlane32_swap(a1, b1, false, false); \
        u32x4 w = {r0[0], r1[0], r0[1], r1[1]}; OUT = *reinterpret_cast<bf16x8*>(&w); } while (0)
    PK4(p0, 0, pa0); PK4(p0, 8, pa1); PK4(p1, 0, pa2); PK4(p1, 8, pa3);
#undef PK4
}
template <int KB>
__device__ __forceinline__ void qkt(f32x16& p0, f32x16& p1, const char* K_lds, int r32, int hi, const bf16x8* qr, const f32x16& minit) {
    const char* kb[4];
#pragma unroll
    for (int dd = 0; dd < 4; ++dd) kb[dd] = K_lds + KB * SHM_K + KSWZ(r32, (dd * 16 + hi * 8) * 2);
#pragma unroll
    for (int d0 = 0; d0 < 8; ++d0) { const char* a = kb[d0 & 3] + (d0 >> 2) * 128;
        bf16x8 b0 = *reinterpret_cast<const bf16x8*>(a);
        bf16x8 b1 = *reinterpret_cast<const bf16x8*>(a + 32 * 256);
        p0 = __builtin_amdgcn_mfma_f32_32x32x16_bf16(b0, qr[d0], d0 == 0 ? minit : p0, 0, 0, 0);
        p1 = __builtin_amdgcn_mfma_f32_32x32x16_bf16(b1, qr[d0], d0 == 0 ? minit : p1, 0, 0, 0); }
}
template <int KB>
__device__ __forceinline__ void qkt_fsm(f32x16& x0, f32x16& x1, const char* K_lds, int r32, int hi, const bf16x8* qr, const f32x16& minit,
                                        f32x16& y0, f32x16& y1, float alpha, float& l_reg, bf16x8& pa0, bf16x8& pa1, bf16x8& pa2, bf16x8& pa3) {
    const char* kb[4];
#pragma unroll
    for (int dd = 0; dd < 4; ++dd) kb[dd] = K_lds + KB * SHM_K + KSWZ(r32, (dd * 16 + hi * 8) * 2);
    bf16x8 b0 = *reinterpret_cast<const bf16x8*>(kb[0]), b1 = *reinterpret_cast<const bf16x8*>(kb[0] + 32 * 256), n0 = b0, n1 = b1;
    float ps = 0.f; unsigned c[16]; u32x4 w0, w1, w2, w3;
#define FS_GAP(g) do { y1[g] = __builtin_amdgcn_exp2f(y1[g]); ps += y0[g]; if ((g) >= 1) ps += y1[(g) - 1]; asm volatile("" : "+v"(ps));       \
        if ((g) < 8) c[g] = cvt_pk_bf16(y0[2 * (g)], y0[2 * (g) + 1]); else if ((g) < 15) c[g] = cvt_pk_bf16(y1[2 * ((g) - 8)], y1[2 * ((g) - 8) + 1]);   \
        if ((g) == 4)  { auto r_ = __builtin_amdgcn_permlane32_swap(c[0], c[2], false, false); w0[0] = r_[0]; w0[2] = r_[1]; }                                  \
        if ((g) == 5)  { auto r_ = __builtin_amdgcn_permlane32_swap(c[1], c[3], false, false); w0[1] = r_[0]; w0[3] = r_[1]; }                                  \
        if ((g) == 8)  { auto r_ = __builtin_amdgcn_permlane32_swap(c[4], c[6], false, false); w1[0] = r_[0]; w1[2] = r_[1]; }                                  \
        if ((g) == 9)  { auto r_ = __builtin_amdgcn_permlane32_swap(c[5], c[7], false, false); w1[1] = r_[0]; w1[3] = r_[1]; }                                  \
        if ((g) == 12) { auto r_ = __builtin_amdgcn_permlane32_swap(c[8], c[10], false, false); w2[0] = r_[0]; w2[2] = r_[1]; }                                 \
        if ((g) == 13) { auto r_ = __builtin_amdgcn_permlane32_swap(c[9], c[11], false, false); w2[1] = r_[0]; w2[3] = r_[1]; }                                 \
        __builtin_amdgcn_sched_barrier(0); } while (0)
#pragma unroll
    for (int d0 = 0; d0 < 8; ++d0) {
        if (d0 < 7) { const char* a = kb[(d0 + 1) & 3] + ((d0 + 1) >> 2) * 128; n0 = *reinterpret_cast<const bf16x8*>(a); n1 = *reinterpret_cast<const bf16x8*>(a + 32 * 256); }
        x0 = __builtin_amdgcn_mfma_f32_32x32x16_bf16(b0, qr[d0], d0 == 0 ? minit : x0, 0, 0, 0);
        FS_GAP(2 * d0);
        x1 = __builtin_amdgcn_mfma_f32_32x32x16_bf16(b1, qr[d0], d0 == 0 ? minit : x1, 0, 0, 0);
        FS_GAP(2 * d0 + 1);
        b0 = n0; b1 = n1;
    }
#undef FS_GAP
    ps += y1[15]; c[15] = cvt_pk_bf16(y1[14], y1[15]);
    { auto r_ = __builtin_amdgcn_permlane32_swap(c[12], c[14], false, false); w3[0] = r_[0]; w3[2] = r_[1]; }
    { auto r_ = __builtin_amdgcn_permlane32_swap(c[13], c[15], false, false); w3[1] = r_[0]; w3[3] = r_[1]; }
    { auto rr = __builtin_amdgcn_permlane32_swap(__float_as_uint(ps), __float_as_uint(ps), false, false);
      ps = __uint_as_float(rr[0]) + __uint_as_float(rr[1]); }
    l_reg = l_reg * alpha + ps;
    pa0 = *reinterpret_cast<bf16x8*>(&w0); pa1 = *reinterpret_cast<bf16x8*>(&w1); pa2 = *reinterpret_cast<bf16x8*>(&w2); pa3 = *reinterpret_cast<bf16x8*>(&w3);
}
template <int VB>
__device__ __forceinline__ void pv_tile(f32x16* o, int vb0, bf16x8 pa0, bf16x8 pa1, bf16x8 pa2, bf16x8 pa3) {
#define TRRD(dst, off) asm volatile("ds_read_b64_tr_b16 %0, %1 offset:%2" : "=&v"(dst) : "v"(vb0), "i"(off) : "memory")
#define PV_D0(d0) do { s16x4 l0, l1, l2, l3, h0, h1, h2, h3; constexpr int b_ = VB * SHM_V + v_rd_off(d0, 0, 0); \
        TRRD(l0, b_); TRRD(h0, b_ + 2048); TRRD(l1, b_ + 4096); TRRD(h1, b_ + 6144); TRRD(l2, b_ + 8192); TRRD(h2, b_ + 10240); TRRD(l3, b_ + 12288); TRRD(h3, b_ + 14336); \
        asm volatile("s_waitcnt lgkmcnt(0)" ::: "memory"); SBAR();   \
        o[d0] = __builtin_amdgcn_mfma_f32_32x32x16_bf16(pa0, (bf16x8){l0[0], l0[1], l0[2], l0[3], h0[0], h0[1], h0[2], h0[3]}, o[d0], 0, 0, 0);   \
        o[d0] = __builtin_amdgcn_mfma_f32_32x32x16_bf16(pa1, (bf16x8){l1[0], l1[1], l1[2], l1[3], h1[0], h1[1], h1[2], h1[3]}, o[d0], 0, 0, 0);   \
        o[d0] = __builtin_amdgcn_mfma_f32_32x32x16_bf16(pa2, (bf16x8){l2[0], l2[1], l2[2], l2[3], h2[0], h2[1], h2[2], h2[3]}, o[d0], 0, 0, 0);   \
        o[d0] = __builtin_amdgcn_mfma_f32_32x32x16_bf16(pa3, (bf16x8){l3[0], l3[1], l3[2], l3[3], h3[0], h3[1], h3[2], h3[3]}, o[d0], 0, 0, 0); } while (0)
    PV_D0(0); PV_D0(1); PV_D0(2); PV_D0(3);
#undef PV_D0
#undef TRRD
}

template <int VB>
__device__ __forceinline__ float pv_tile_sm(f32x16* o, int vb0, bf16x8 pa0, bf16x8 pa1, bf16x8 pa2, bf16x8 pa3, f32x16& x0, f32x16& x1, unsigned long long mw, int hi) {
    const unsigned long long sh = mw >> (4 * hi);
    const int lo = (int)(unsigned)sh, hh = (int)(unsigned)(sh >> 32);
    const int NEG = (int)0xff800000u;
    float pmax = __int_as_float(NEG);
#define TRRD(dst, off) asm volatile("ds_read_b64_tr_b16 %0, %1 offset:%2" : "=&v"(dst) : "v"(vb0), "i"(off) : "memory")
#define PV_LD(S_, d0) do { constexpr int b_ = VB * SHM_V + v_rd_off(d0, 0, 0); \
        TRRD(S_##l0, b_); TRRD(S_##h0, b_ + 2048); TRRD(S_##l1, b_ + 4096); TRRD(S_##h1, b_ + 6144); TRRD(S_##l2, b_ + 8192); TRRD(S_##h2, b_ + 10240); TRRD(S_##l3, b_ + 12288); TRRD(S_##h3, b_ + 14336); } while (0)
#define PV_WAIT() do { asm volatile("s_waitcnt lgkmcnt(0)" ::: "memory"); SBAR(); } while (0)
#define PV_MMA(S_, d0) do { \
        o[d0] = __builtin_amdgcn_mfma_f32_32x32x16_bf16(pa0, (bf16x8){S_##l0[0], S_##l0[1], S_##l0[2], S_##l0[3], S_##h0[0], S_##h0[1], S_##h0[2], S_##h0[3]}, o[d0], 0, 0, 0);   \
        o[d0] = __builtin_amdgcn_mfma_f32_32x32x16_bf16(pa1, (bf16x8){S_##l1[0], S_##l1[1], S_##l1[2], S_##l1[3], S_##h1[0], S_##h1[1], S_##h1[2], S_##h1[3]}, o[d0], 0, 0, 0);   \
        o[d0] = __builtin_amdgcn_mfma_f32_32x32x16_bf16(pa2, (bf16x8){S_##l2[0], S_##l2[1], S_##l2[2], S_##l2[3], S_##h2[0], S_##h2[1], S_##h2[2], S_##h2[3]}, o[d0], 0, 0, 0);   \
        o[d0] = __builtin_amdgcn_mfma_f32_32x32x16_bf16(pa3, (bf16x8){S_##l3[0], S_##l3[1], S_##l3[2], S_##l3[3], S_##h3[0], S_##h3[1], S_##h3[2], S_##h3[3]}, o[d0], 0, 0, 0); } while (0)
#define SM_SLICE(d0) do { _Pragma("unroll") for (int r = 4 * (d0); r < 4 * (d0) + 4; ++r) { const int c = (r & 3) + 8 * (r >> 2);          \
        const int m0 = __builtin_amdgcn_sbfe(lo, c, 1), m1 = __builtin_amdgcn_sbfe(hh, c, 1); float q0 = x0[r], q1 = x1[r];                        \
        asm("v_bfi_b32 %0, %1, %0, %2" : "+v"(q0) : "v"(m0), "s"(NEG)); asm("v_bfi_b32 %0, %1, %0, %2" : "+v"(q1) : "v"(m1), "s"(NEG));             \
        x0[r] = q0; x1[r] = q1; pmax = max3_s(pmax, q0, q1); } } while (0)
    s16x4 Al0, Al1, Al2, Al3, Ah0, Ah1, Ah2, Ah3, Bl0, Bl1, Bl2, Bl3, Bh0, Bh1, Bh2, Bh3;
    PV_LD(A, 0); PV_WAIT();
    PV_MMA(A, 0); PV_LD(B, 1); SM_SLICE(0); PV_WAIT();
    PV_MMA(B, 1); PV_LD(A, 2); SM_SLICE(1); PV_WAIT();
    PV_MMA(A, 2); PV_LD(B, 3); SM_SLICE(2); PV_WAIT();
    PV_MMA(B, 3); SM_SLICE(3);
#undef SM_SLICE
#undef PV_MMA
#undef PV_WAIT
#undef PV_LD
#undef TRRD
    return pmax;
}

struct Blk { const bf16_t* Q; const bf16_t* K; const bf16_t* V; const bf16_t* Gt; bf16_t* Y; const unsigned long long* M; int P0; int NT; };
struct Seam { bf16x8 qr[8]; bf16x8 st_v0, st_v1, st_k0, st_k1; };
#define ROW(p, k0, rr) ((p) + (size_t)((k0) + (rr)) * RS + sc)
#define VMW() asm volatile("s_waitcnt vmcnt(0)" ::: "memory")
#define VMWN(n) asm volatile("s_waitcnt vmcnt(%0)" :: "i"(n) : "memory")
#define SLOAD_H(Kp, Vp, k0) do { const char* kt_ = (const char*)(Kp) + (size_t)(k0) * (RS * 2); const char* vt_ = (const char*)(Vp) + (size_t)(k0) * (RS * 2);   \
                         S.st_v0 = *(const bf16x8*)(vt_ + ldo0); S.st_v1 = *(const bf16x8*)(vt_ + 32 * RS * 2 + ldo0);              \
                         S.st_k0 = *(const bf16x8*)(kt_ + ldo0); S.st_k1 = *(const bf16x8*)(kt_ + 32 * RS * 2 + ldo0); } while (0)
#define SWRITE_HK(bf) do { *(bf16x8*)(K_lds + (bf) * SHM_K + kws) = S.st_k0; *(bf16x8*)(K_lds + (bf) * SHM_K + kws + 32 * 256) = S.st_k1; } while (0)
#define SWRITE_HV(bf) do { *(bf16x8*)(V_lds + (bf) * SHM_V + vst0) = S.st_v0; *(bf16x8*)(V_lds + (bf) * SHM_V + vst0 + 8192) = S.st_v1; } while (0)
#define SWRITE_H(bf) do { SWRITE_HV(bf); SWRITE_HK(bf); } while (0)
__device__ __forceinline__ void prime(const Blk& cur, char* lds, Seam& S, int tid) {
    const int wid = __builtin_amdgcn_readfirstlane(tid >> 6), lane = tid & 63, r32 = lane & 31, hi = lane >> 5;
    const int sr = tid >> 4, sc = (tid & 15) * 8, kws = KSWZ(sr, sc * 2); char* K_lds = lds + 2 * SHM_V;
    const unsigned ldo0 = (unsigned)(sr * RS + sc) * 2u;
    const int kb0 = 3 * KVBLK;
#pragma unroll
    for (int d0 = 0; d0 < 8; ++d0) S.qr[d0] = load8(cur.Q + (size_t)(cur.P0 + wid * QBLK + r32) * RS + d0 * 16 + hi * 8);
    SLOAD_H(cur.K, cur.V, kb0); VMW(); SWRITE_HK(0);
    __syncthreads();
}
__device__ __forceinline__ void block(const Blk& cur, const Blk& nxt, const float* lutg, char* lds, Seam& S, int tid, const bool dry) {
    const int wid = __builtin_amdgcn_readfirstlane(tid >> 6), lane = tid & 63, r32 = lane & 31, hi = lane >> 5;
    const int NT = cur.NT;
    const int kbn = 3 * KVBLK;
    const int qlo = cur.P0 + wid * QBLK, qm = qlo + r32 - 4 * hi;
    char* V_lds = lds; char* K_lds = lds + 2 * SHM_V;
    float* ws = (float*)(lds + WS_OFF) + wid * 64; float* li_l = ws, * al_l = ws + 32;
    float* lut = (float*)(lds + LUT_OFF);
    { int tl = tid; asm volatile("" : "+v"(tl)); if (tl < 128) lut[tl] = lutg[tl]; }
    float m_reg = 0.f, l_reg = 0; f32x16 o[4] = {}; f32x16 minit = {};
    const int sr = tid >> 4, sc = (tid & 15) * 8, vst0 = v_st(sr, sc), kws = KSWZ(sr, sc * 2);
    const unsigned ldo0 = (unsigned)(sr * RS + sc) * 2u;
    const int vb0 = (int)(uintptr_t)V_lds + v_rd_base(lane);
    const bf16_t* Kh = cur.K; const bf16_t* Vh = cur.V;
    const unsigned moff = (unsigned)(wid * QBLK + r32) * 8u;
#define RESC(a) do { if (__any((a) < 1.f)) { if (hi == 0) al_l[r32] = (a); asm volatile("s_waitcnt lgkmcnt(0)" ::: "memory");              \
                     for (int d_ = 0; d_ < 4; ++d_) for (int r = 0; r < 16; ++r) o[d_][r] *= al_l[crow(r, hi)]; } } while (0)
#define KBASE(t) ((3 + (t)) * KVBLK)
#define MLOAD(t) (*(const unsigned long long*)((const char*)cur.M + (size_t)(3 + (t)) * 2048 + moff))
#define MASKT(P0_, P1_, mw_, t) do { const int kb_ = KBASE(t); if (kb_ + KVBLK - 1 + 113 > qlo) bias_tile(P0_, P1_, qm - kb_, lut); mask_tile(P0_, P1_, mw_, hi); } while (0)
    constexpr int NQL = 8;
#define SEAM_K0() do { VMWN(NQL); SWRITE_HK(0); SBAR(); } while (0)
    f32x16 pA0, pA1, pB0, pB1; float alA, alB; bf16x8 pa0, pa1, pa2, pa3; unsigned long long mwA, mwB;
    SWRITE_HV(0); SBAR();
    mwA = MLOAD(0);
    if (NT > 1) SLOAD_H(Kh, Vh, KBASE(1));
    SBAR(); qkt<0>(pA0, pA1, K_lds, r32, hi, S.qr, minit);
    __syncthreads();
    asm volatile("s_nop 15\n\ts_nop 3" ::: "memory");
    MASKT(pA0, pA1, mwA, 0); partialSM(pA0, pA1, m_reg, minit, alA);
    if (NT > 1) { VMW(); SWRITE_HK(1); }
    __syncthreads();
#define HALF_STEP(PX0, PX1, mnX, alX, mwX, PY0, PY1, alY, t, KB, VB, SB) do {                                                      \
        SWRITE_HV(KB); SBAR(); mwX = MLOAD(t); if ((t) + 1 < NT) { SLOAD_H(Kh, Vh, KBASE((t) + 1)); SBAR(); }       \
        qkt_fsm<KB>(PX0, PX1, K_lds, r32, hi, S.qr, minit, PY0, PY1, alY, l_reg, pa0, pa1, pa2, pa3); SBAR();      \
        { const int kb_ = KBASE(t); if (kb_ + KVBLK - 1 + 113 > qlo) { int lt_ = r32 | (hi << 5); asm volatile("" : "+v"(lt_)); bias_tile(PX0, PX1, qlo + (lt_ & 31) - 4 * (lt_ >> 5) - kb_, lut); } }   \
        { const float pm_ = pv_tile_sm<VB>(o, vb0, pa0, pa1, pa2, pa3, PX0, PX1, mwX, hi);                                                                          \
          if ((t) + 1 < NT) { VMW(); SWRITE_HK(SB); }                   \
          partialSM_post(PX0, PX1, pm_, m_reg, minit, alX); }                                                                                                              \
        RESC(alX); __syncthreads(); } while (0)
    for (int t = 1; t + 1 < NT; t += 2) {
        HALF_STEP(pB0, pB1, mnB, alB, mwB, pA0, pA1, alA, t, 1, 0, 0);
        HALF_STEP(pA0, pA1, mnA, alA, mwA, pB0, pB1, alB, t + 1, 0, 1, 1);
    }
    const bool even = (NT & 1) == 0;
    if (even) { SWRITE_HV(1); SBAR(); mwB = MLOAD(NT - 1); qkt<1>(pB0, pB1, K_lds, r32, hi, S.qr, minit); SBAR(); }
    SLOAD_H(nxt.K, nxt.V, kbn); SBAR();
    unsigned qlo_; { int lt = r32 | (hi << 5); asm volatile("" : "+v"(lt)); qlo_ = (unsigned)((lt & 31) * RS + (lt >> 5) * 8) * 2u; }
#pragma unroll
    for (int d0 = 0; d0 < 8; ++d0) S.qr[d0] = *(const bf16x8*)((const char*)(nxt.Q + (size_t)(nxt.P0 + wid * QBLK) * RS) + qlo_ + d0 * 32);
    SBAR();
    finishSM(pA0, pA1, alA, l_reg, pa0, pa1, pa2, pa3); SBAR();
    pv_tile<0>(o, vb0, pa0, pa1, pa2, pa3);
    if (even) { MASKT(pB0, pB1, mwB, NT - 1); partialSM(pB0, pB1, m_reg, minit, alB); __syncthreads(); RESC(alB);
        finishSM(pB0, pB1, alB, l_reg, pa0, pa1, pa2, pa3); SBAR(); pv_tile<1>(o, vb0, pa0, pa1, pa2, pa3); }
    SBAR(); SEAM_K0();
    if (hi == 0) li_l[r32] = l_reg; asm volatile("s_waitcnt lgkmcnt(0)" ::: "memory");
    { int ln = r32 | (hi << 5); asm volatile("" : "+v"(ln));
      char* et = lds + EPI_OFF + (qlo & 255) * 256;
      char* eb = et + (ln >> 5) * 1024 + (ln & 31) * 2; const float* lb = li_l + (ln >> 5) * 4;
      u32x4 gw[4], yw[4], gx[4], yx[4];
#pragma unroll
      for (int i4 = 0; i4 < 4; ++i4) { const int idx = i4 * 64 + ln; const size_t off = (size_t)(qlo + (idx >> 4)) * RS + (idx & 15) * 8;
          gw[i4] = *(const u32x4*)(cur.Gt + off); yw[i4] = *(const u32x4*)(cur.Y + off); }
#pragma unroll
      for (int r = 0; r < 16; ++r) { const int cr = (r & 3) + 8 * (r >> 2); const float rli = __builtin_amdgcn_rcpf(lb[cr]);
#pragma unroll
          for (int d0 = 0; d0 < 4; ++d0) *(unsigned short*)(eb + cr * 256 + d0 * 64) = (unsigned short)cvt_pk_bf16(o[d0][r] * rli, 0.f); }
      asm volatile("s_waitcnt lgkmcnt(0)" ::: "memory");
#pragma unroll
      for (int i4 = 0; i4 < 4; ++i4) { const int idx = (4 + i4) * 64 + ln; const size_t off = (size_t)(qlo + (idx >> 4)) * RS + (idx & 15) * 8;
          gx[i4] = *(const u32x4*)(cur.Gt + off); yx[i4] = *(const u32x4*)(cur.Y + off); }
#pragma unroll
      for (int i8 = 0; i8 < 8; ++i8) { const int idx = i8 * 64 + ln, row = idx >> 4, ch = idx & 15; const int a = qlo + row;
          const u32x4 ov = *(const u32x4*)(et + row * 256 + ch * 16); const u32x4 g_ = i8 < 4 ? gw[i8 & 3] : gx[i8 & 3], y_ = i8 < 4 ? yw[i8 & 3] : yx[i8 & 3]; u32x4 res;
#pragma unroll
          for (int j = 0; j < 4; ++j) res[j] = cvt_pk_bf16(bf_lo(y_[j]) + sigm_fast(bf_lo(g_[j])) * bf_lo(ov[j]), bf_hi(y_[j]) + sigm_fast(bf_hi(g_[j])) * bf_hi(ov[j]));
          if (a >= PADF && !dry) *(u32x4*)(cur.Y + (size_t)a * RS + ch * 8) = res; } }
    __syncthreads();
#undef RESC
#undef KBASE
#undef MLOAD
#undef MASKT
#undef SEAM_K0
#undef HALF_STEP
}
#undef ROW
#undef VMW
#undef VMWN
#undef SLOAD_H
#undef SWRITE_HK
#undef SWRITE_HV
#undef SWRITE_H
#undef KSWZ
#undef SBAR
}
__device__ __forceinline__ att::Blk attn_blk(int i, const bf16_t* Q, const bf16_t* K, const bf16_t* V, const bf16_t* Gt, bf16_t* Y, const unsigned long long* MASK) {
    const int qblk = 64 - (i >> 4), bh = i & 15, b = bh >> 3, h = bh & 7; const size_t base = (size_t)b * RA * D + h * HD;
    att::Blk r; r.Q = Q + base; r.K = K + base; r.V = V + base; r.Gt = Gt + base; r.Y = Y + base; r.M = mask_chunk(const_cast<unsigned long long*>(MASK), b, qblk, 0); r.P0 = 256 * qblk; r.NT = 4 * qblk + 1;
    return r;
}
__device__ __forceinline__ void phase_attention(LAS unsigned char* lds_, const bf16_t* Q, const bf16_t* K, const bf16_t* V, const bf16_t* Gt, bf16_t* Y, const unsigned long long* MASK, const float* LUT, unsigned* ctr, const bool dry, const int wid0) {
    const int tid = opaque_tid(wid0);
    char* lds = (char*)lds_;
    constexpr int NITEM = 16 * 65;
    volatile LAS unsigned* slot = (volatile LAS unsigned*)(lds_ + MISC_OFF) + 17;
    int i = queue_pop(ctr, slot, tid);
    if (i >= NITEM) return;
    att::Blk cur = attn_blk(i, Q, K, V, Gt, Y, MASK);
    att::Seam S;
    if (__builtin_amdgcn_readfirstlane(tid) >= 256) __builtin_amdgcn_s_setprio(1);
    att::prime(cur, lds, S, tid);
    for (;;) {
        const int in = queue_pop(ctr, slot, tid);
        const bool last = in >= NITEM;
        const att::Blk nxt = last ? cur : attn_blk(in, Q, K, V, Gt, Y, MASK);
        att::block(cur, nxt, LUT + (i & 7) * 128, lds, S, tid, dry);
        if (last) break;
        cur = nxt; i = in;
    }
    __builtin_amdgcn_s_setprio(0);
}

#ifndef N_LAUNCH_MODE
#define N_LAUNCH_MODE 1
#endif
constexpr int NPH_LAYER = 14;
constexpr int PH_FINAL = 1 + DEPTH * NPH_LAYER;
#ifndef ENABLE_ATTN
#define ENABLE_ATTN 1
#endif

#ifndef PMASK
#define PMASK 0xFFFFFFFFu
#endif
#define RUN(p) ((((PMASK) >> ((p) == 0 ? 30 : (p) == PH_FINAL ? 31 : ((p) - 1) % NPH_LAYER)) & 1u) && lo <= (p) && (p) < hi)
#ifndef PROBE_BARX
#define PROBE_BARX 0
#endif
#define GRIDBAR() do { GAS unsigned char* wsbg_ = (GAS unsigned char*)A.ws; asm volatile("" : "+s"(wsbg_)); unsigned char* wsb_ = (unsigned char*)wsbg_; XcdBarrier b_; b_.bar = (unsigned*)(wsb_ + WS_CTL) + 4096; b_.x = xb_xcc_id(); b_.st = (volatile LAS unsigned*)(lds + MISC_OFF) + 8; xcd_barrier(b_, opaque_tid(wid0)); } while (0)
#define SEAM(p) do { if (RUN((p) + 1)) { GRIDBAR(); for (int _b = 0; _b < PROBE_BARX; ++_b) GRIDBAR(); } } while (0)
#ifndef PROBE_DUP
#define PROBE_DUP 0u
#endif
#ifndef PROBE_DUPBAR
#define PROBE_DUPBAR 0
#endif
#define DUPRUN(k, ...) do { if constexpr (((PROBE_DUP) >> (k)) & 1u) { __VA_ARGS__ if (PROBE_DUPBAR) GRIDBAR(); } } while (0)
#define PHASE_BEGIN() GAS unsigned char* wsg_ = (GAS unsigned char*)A.ws; asm volatile("" : "+s"(wsg_)); unsigned char* ws = (unsigned char*)wsg_; const int G = gridDim.x; \
    bf16_t* SA0 = (bf16_t*)(ws + WS_A0); bf16_t* SA1 = (bf16_t*)(ws + WS_A1); bf16_t* SB0 = (bf16_t*)(ws + WS_B0); bf16_t* SB1 = (bf16_t*)(ws + WS_B1); bf16_t* SB2 = (bf16_t*)(ws + WS_B2); bf16_t* SB3 = (bf16_t*)(ws + WS_B3); \
    bf16_t* QI = (bf16_t*)(ws + WS_QI); bf16_t* KI = (bf16_t*)(ws + WS_KI); float* WI = (float*)(ws + WS_WI); float* AGG = (float*)(ws + WS_AGG); float* CARRY = (float*)(ws + WS_CARRY); float* hmeta = (float*)(ws + WS_HMETA); \
    (void)G; (void)SA0; (void)SA1; (void)SB0; (void)SB1; (void)SB2; (void)SB3; (void)QI; (void)KI; (void)WI; (void)AGG; (void)CARRY; (void)hmeta;

template <int l>
__device__ __forceinline__ void layer_phases(const Args& A, LAS unsigned char* lds, const int lo, const int hi, const int wid0) {
        constexpr int pb = 1 + l * NPH_LAYER;
        if (RUN(pb + 0)) { PHASE_BEGIN(); DUPRUN(0, { if (l == 0) phase_rmsnorm<0>(A, A.norm1_g, SA0, wid0); else phase_rmsnorm<1>(A, A.norm1_g + l * D, SA0, wid0); }); if (l == 0) phase_rmsnorm<0>(A, A.norm1_g, SA0, wid0, SB1, SB2); else phase_rmsnorm<1>(A, A.norm1_g + l * D, SA0, wid0, SB1, SB2); SEAM(pb + 0); }
        if (RUN(pb + 1)) { PHASE_BEGIN(); const bf16_t* Win = (const bf16_t*)(ws + WS_WIN + (size_t)l * 16 * MiB);
            pg8::Gemm g{SA0, Win, D, D, D}; pg8::StaticOrder S; S.init(NB * SEQ, NA, G, (int)blockIdx.x);
            pg8::EpiProj E{SB0, SB1, SB2, SB2, QI, KI, WI}; DUPRUN(1, { pg8::gemm_phase(lds, g, S, E, wid0); }); pg8::gemm_phase(lds, g, S, E, wid0);
            { MEpiProj ME{SB0, SB1, SB2, SB2, QI, KI, WI}; meta_gemm(lds, SA0, D, Win, D, NA, D, 1, 1, ME, wid0); } SEAM(pb + 1); }
        if (RUN(pb + 2)) { PHASE_BEGIN(); DUPRUN(2, { phase_conv(SB1, SB3, A.conv_w + l * 4 * D, A.conv_b + l * D, G, wid0); }); phase_conv(SB1, SB3, A.conv_w + l * 4 * D, A.conv_b + l * D, G, wid0); SEAM(pb + 2); }
        if (RUN(pb + 3)) { PHASE_BEGIN(); const bf16_t* Wrg = (const bf16_t*)(ws + WS_WRG + (size_t)l * MiB);
            pg8::Gemm g{SB3, Wrg, D, 256, 256}; pg8::GroupOrder S; S.init(NB * SEQ, 2048, G, (int)blockIdx.x);
            pg8::EpiRGPre E{SA1, SB1}; DUPRUN(3, { pg8::gemm_phase(lds, g, S, E, wid0); }); pg8::gemm_phase(lds, g, S, E, wid0);
            { MEpiRG ME{SA1, SB1}; meta_gemm(lds, SB3, D, Wrg, 256, 2048, 256, 1, 4, ME, wid0); } SEAM(pb + 3); }
        if (RUN(pb + 4)) { PHASE_BEGIN(); DUPRUN(4, { phase_scan_local(SA1, SB1, SB3, A.b_rg_a + l * D, A.b_rg_x + l * D, A.lru_lambda + l * D, AGG, G, A.ph_hi > 0, wid0); }); phase_scan_local(SA1, SB1, SB3, A.b_rg_a + l * D, A.b_rg_x + l * D, A.lru_lambda + l * D, AGG, G, false, wid0); SEAM(pb + 4); }
        if (RUN(pb + 5)) { PHASE_BEGIN(); DUPRUN(5, { phase_scan_carry(AGG, CARRY, wid0); }); phase_scan_carry(AGG, CARRY, wid0); SEAM(pb + 5); }
        if (RUN(pb + 6)) { PHASE_BEGIN(); DUPRUN(6, { phase_scan_apply((const _Float16*)SA1, (const _Float16*)SB1, CARRY, SB0, SB2, SB3, G, wid0); }); phase_scan_apply((const _Float16*)SA1, (const _Float16*)SB1, CARRY, SB0, SB2, SB3, G, wid0); SEAM(pb + 6); }
        if (RUN(pb + 7)) {
#if ENABLE_ATTN
            PHASE_BEGIN(); const bf16_t* Win = (const bf16_t*)(ws + WS_WIN + (size_t)l * 16 * MiB);
            pg8::Gemm g{SA0, Win + (size_t)NA * D, D, D, D}; pg8::StaticOrder S; S.init(NB * SEQ, NBP, G, (int)blockIdx.x);
            pg8::EpiProj E{SB0, SB1, SB2, SA1, QI, KI, WI}; DUPRUN(7, { pg8::gemm_phase(lds, g, S, E, wid0); }); pg8::gemm_phase(lds, g, S, E, wid0);
            { MEpiProj ME{SB0, SB1, SB2, SA1, QI, KI, WI}; meta_gemm(lds, SA0, D, Win + (size_t)NA * D, D, NBP, D, 1, 1, ME, wid0); }
#endif
            SEAM(pb + 7); }
        if (RUN(pb + 8)) {
#if ENABLE_ATTN
            PHASE_BEGIN(); unsigned* qc = (unsigned*)(ws + WS_CTL) + 8192 + (l * 4) * 64; DUPRUN(8, { phase_indexer(lds, QI, KI, WI, (unsigned long long*)SA0, qc + 64, wid0); __syncthreads(); }); phase_indexer(lds, QI, KI, WI, (unsigned long long*)SA0, qc, wid0);
#endif
            SEAM(pb + 8); }
        if (RUN(pb + 9)) {
#if ENABLE_ATTN
            PHASE_BEGIN(); unsigned* qc = (unsigned*)(ws + WS_CTL) + 8192 + (l * 4 + 2) * 64; DUPRUN(9, { phase_attention(lds, SB0, SB1, SB2, SA1, SB3, (const unsigned long long*)SA0, (const float*)(ws + WS_LUT), qc + 64, A.ph_hi > 0, wid0); __syncthreads(); }); phase_attention(lds, SB0, SB1, SB2, SA1, SB3, (const unsigned long long*)SA0, (const float*)(ws + WS_LUT), qc, false, wid0);
#endif
            SEAM(pb + 9); }
        if (RUN(pb + 10)) { PHASE_BEGIN(); const bf16_t* Wout = (const bf16_t*)(ws + WS_WOUT + (size_t)l * 2 * MiB);
            pg8::Gemm g{SB3, Wout, D, D, D}; pg8::StaticOrder S; S.init(NB * SEQ, D, G, (int)blockIdx.x);
            pg8::EpiRes E{A.out, hmeta, 0, l == 0 ? (long)(A.x - A.out) : 0l}; DUPRUN(10, { pg8::EpiRes Ed{A.out, hmeta, A.ph_hi > 0, 0l}; pg8::gemm_phase(lds, g, S, Ed, wid0); }); pg8::gemm_phase(lds, g, S, E, wid0);
            if (l + 1 < DEPTH) { MEpiRes ME{A.out, hmeta}; meta_gemm(lds, SB3, D, Wout, D, D, D, 4, 1, ME, wid0); } SEAM(pb + 10); }
        if (RUN(pb + 11)) { PHASE_BEGIN(); DUPRUN(11, { phase_rmsnorm<1>(A, A.norm2_g + l * D, SA0, wid0); }); phase_rmsnorm<1>(A, A.norm2_g + l * D, SA0, wid0); SEAM(pb + 11); }
        if (RUN(pb + 12)) { PHASE_BEGIN(); const bf16_t* W1 = (const bf16_t*)(ws + WS_W1 + (size_t)l * 8 * MiB);
            pg8::Gemm g{SA0, W1, D, D, D}; pg8::StaticOrder S; S.init(NB * SEQ, FF, G, (int)blockIdx.x);
            pg8::EpiRelu2 E{SB0, FF}; DUPRUN(12, { pg8::gemm_phase(lds, g, S, E, wid0); }); pg8::gemm_phase(lds, g, S, E, wid0);
            if (l + 1 < DEPTH) { MEpiRelu2 ME{SB0}; meta_gemm(lds, SA0, D, W1, D, FF, D, 1, 1, ME, wid0); } SEAM(pb + 12); }
        if (RUN(pb + 13)) { PHASE_BEGIN(); const bf16_t* W2 = (const bf16_t*)(ws + WS_W2 + (size_t)l * 8 * MiB);
            pg8::Gemm g{SB0, W2, FF, FF, FF}; pg8::StaticOrder S; S.init(NB * SEQ, D, G, (int)blockIdx.x);
            pg8::EpiRes E{A.out, hmeta, 0, 0l}; DUPRUN(13, { pg8::EpiRes Ed{A.out, hmeta, A.ph_hi > 0, 0l}; pg8::gemm_phase(lds, g, S, Ed, wid0); }); pg8::gemm_phase(lds, g, S, E, wid0);
            if (l + 1 < DEPTH) { MEpiRes ME{A.out, hmeta}; meta_gemm(lds, SB0, FF, W2, FF, D, FF, 4, 1, ME, wid0); } SEAM(pb + 13); }
}

__global__ void __launch_bounds__(NTHREADS, 2) mega_fwd(Args A_) {
    Args A = A_;
    A.x = as_global(A.x); A.norm1_g = as_global(A.norm1_g); A.w_in = as_global(A.w_in); A.conv_w = as_global(A.conv_w); A.conv_b = as_global(A.conv_b); A.w_rg_a = as_global(A.w_rg_a); A.b_rg_a = as_global(A.b_rg_a);
    A.w_rg_x = as_global(A.w_rg_x); A.b_rg_x = as_global(A.b_rg_x); A.lru_lambda = as_global(A.lru_lambda); A.w_out = as_global(A.w_out); A.norm2_g = as_global(A.norm2_g); A.w_mlp1 = as_global(A.w_mlp1); A.w_mlp2 = as_global(A.w_mlp2);
    A.rel_bias = as_global(A.rel_bias); A.meta = as_global(A.meta); A.final_g = as_global(A.final_g); A.out = as_global(A.out); A.ws = as_global(A.ws);
    extern __shared__ __attribute__((aligned(16))) unsigned char lds_raw[];
    LAS unsigned char* lds = (LAS unsigned char*)lds_raw;
    volatile LAS unsigned* MISC = (volatile LAS unsigned*)(lds + MISC_OFF);
    const int wid0 = __builtin_amdgcn_readfirstlane(threadIdx.x >> 6);
    if (threadIdx.x < 64) MISC[threadIdx.x] = 0u;
    __syncthreads();
    (void)xcd_barrier_post((unsigned*)(A.ws + WS_CTL) + 4096, MISC + 8);
    const int lo = A.ph_lo, hi = A.ph_hi;
    if (RUN(0)) { DUPRUN(14, { phase_prologue(A, lds, wid0); __syncthreads(); }); phase_prologue(A, lds, wid0); __syncthreads(); if (N_LAUNCH_MODE == 0) SEAM(0); }
    layer_phases<0>(A, lds, lo, hi, wid0);
    layer_phases<1>(A, lds, lo, hi, wid0);
    if (RUN(PH_FINAL)) phase_rmsnorm<2>(A, A.final_g, nullptr, wid0);
}
#undef RUN
#undef SEAM

extern "C" void kernel_launch(void* const* d_in, const int* in_sizes, int n_in, void* d_out, int out_size, void* d_ws, size_t ws_size, hipStream_t stream) {
    static int grid = 0;
    if (grid == 0) {
        if (n_in != 17 || out_size != NB * SEQ * D || ws_size < WS_END) { fprintf(stderr, "kernel_launch: unexpected shapes (n_in %d out %d ws %zu)\n", n_in, out_size, ws_size); grid = -1; return; }
        int dev = 0, cus = 0, per_cu = 0;
        if (hipGetDevice(&dev) != hipSuccess || hipDeviceGetAttribute(&cus, hipDeviceAttributeMultiprocessorCount, dev) != hipSuccess) { grid = -1; return; }
        if (hipFuncSetAttribute((const void*)mega_fwd, hipFuncAttributeMaxDynamicSharedMemorySize, LDS_BYTES) != hipSuccess) { fprintf(stderr, "kernel_launch: hipFuncSetAttribute failed\n"); grid = -1; return; }
        if (hipOccupancyMaxActiveBlocksPerMultiprocessor(&per_cu, (const void*)mega_fwd, NTHREADS, LDS_BYTES) != hipSuccess || per_cu < 1) { fprintf(stderr, "kernel_launch: occupancy query says %d\n", per_cu); }
        (void)hipGetLastError();
        grid = cus;
    }
    if (grid < 0) return;
    (void)hipMemsetAsync((char*)d_ws + WS_CTL, 0, CTL_ZERO_BYTES, stream);
    Args a{};
    a.x = (const float*)d_in[0]; a.norm1_g = (const float*)d_in[1]; a.w_in = (const float*)d_in[2]; a.conv_w = (const float*)d_in[3]; a.conv_b = (const float*)d_in[4];
    a.w_rg_a = (const float*)d_in[5]; a.b_rg_a = (const float*)d_in[6]; a.w_rg_x = (const float*)d_in[7]; a.b_rg_x = (const float*)d_in[8]; a.lru_lambda = (const float*)d_in[9];
    a.w_out = (const float*)d_in[10]; a.norm2_g = (const float*)d_in[11]; a.w_mlp1 = (const float*)d_in[12]; a.w_mlp2 = (const float*)d_in[13]; a.rel_bias = (const float*)d_in[14];
    a.meta = (const float*)d_in[15]; a.final_g = (const float*)d_in[16]; a.out = (float*)d_out; a.ws = (unsigned char*)d_ws;
#if N_LAUNCH_MODE == 1
    a.ph_lo = 0; a.ph_hi = PH_FINAL + 1;
    hipLaunchKernelGGL(mega_fwd, dim3(grid), dim3(NTHREADS), LDS_BYTES, stream, a);
#else
    for (int p = 0; p <= PH_FINAL; ++p) { a.ph_lo = p; a.ph_hi = p + 1; hipLaunchKernelGGL(mega_fwd, dim3(grid), dim3(NTHREADS), LDS_BYTES, stream, a); }
#endif
}
```

```cpp
#include <hip/hip_runtime.h>
#include <cstdio>
#include <cstdint>

#define LAS __attribute__((address_space(3)))
typedef unsigned short bf16_t;
typedef short bf16x8 __attribute__((ext_vector_type(8)));
typedef short s16x4 __attribute__((ext_vector_type(4)));
typedef float f32x4 __attribute__((ext_vector_type(4)));
typedef float f32x2 __attribute__((ext_vector_type(2)));
typedef float f32x16 __attribute__((ext_vector_type(16)));
typedef unsigned u32x4 __attribute__((ext_vector_type(4)));
typedef unsigned u32x2 __attribute__((ext_vector_type(2)));
typedef _Float16 h16x4 __attribute__((ext_vector_type(4)));
typedef _Float16 h16x2 __attribute__((ext_vector_type(2)));
typedef _Float16 h16x4 __attribute__((ext_vector_type(4)));

constexpr int NB = 2, SEQ = 16384, NMETA = 16, PADF = 240, RA = 16640, R = NB * RA;
constexpr int D = 1024, NH = 8, HD = 128, IH = 8, IDIM = 64, FF = 4096, NIN = 7752, DEPTH = 2;
constexpr float EPS = 1e-6f;
constexpr int NA = 3072, NBP = 4864;
constexpr int WIN_ROWS = NA + NBP;
constexpr int NWAVES = 8, NTHREADS = 512;

constexpr size_t MiB = 1u << 20;
constexpr size_t SLOT = (size_t)R * D * 2;
constexpr size_t WS_CTL = 0, CTL_ZERO_BYTES = 1 * MiB;
constexpr size_t WS_WIN = 1 * MiB;
constexpr size_t WS_WOUT = 33 * MiB;
constexpr size_t WS_W1 = 37 * MiB;
constexpr size_t WS_W2 = 53 * MiB;
constexpr size_t WS_WRG = 69 * MiB;
constexpr size_t WS_HMETA = 71 * MiB;
constexpr size_t WS_WI = 73 * MiB;
constexpr size_t WS_KI = 75 * MiB;
constexpr size_t WS_QI = 80 * MiB;
constexpr size_t WS_AGG = 113 * MiB;
constexpr size_t WS_CARRY = 118 * MiB;
constexpr size_t WS_LUT = 121 * MiB;
constexpr size_t WS_A0 = 122 * MiB, WS_A1 = 187 * MiB, WS_B0 = 252 * MiB, WS_B1 = 317 * MiB, WS_B2 = 382 * MiB, WS_B3 = 447 * MiB, WS_END = 512 * MiB;
static_assert(SLOT == 65 * MiB && WS_B3 + SLOT == WS_END, "ws map");
constexpr int NCHUNK = 256, CHROWS = 65;
constexpr int MASK_CHUNKS_PER_BATCH = 2 * 65 * 66;

constexpr int LDS_BYTES = 147456;
constexpr int MISC_OFF = 131072 + 4096;

#define GAS __attribute__((address_space(1)))
template <class T> __device__ __forceinline__ T* as_global(T* p) { return (T*)(GAS T*)p; }
__device__ __forceinline__ int opaque_tid(int wid0) { int l; asm volatile("v_mbcnt_lo_u32_b32 %0, -1, 0\n\tv_mbcnt_hi_u32_b32 %0, -1, %0" : "=v"(l)); return wid0 * 64 + l; }
__device__ __forceinline__ unsigned cvt_pk_bf16(float lo, float hi) { unsigned r; asm volatile("v_cvt_pk_bf16_f32 %0, %1, %2" : "=v"(r) : "v"(lo), "v"(hi)); return r; }
__device__ __forceinline__ float bf_lo(unsigned w) { return __uint_as_float(w << 16); }
__device__ __forceinline__ float bf_hi(unsigned w) { return __uint_as_float(w & 0xffff0000u); }
__device__ __forceinline__ float wave_sum(float v) {
#pragma unroll
    for (int o = 1; o < 64; o <<= 1) v += __shfl_xor(v, o);
    return v;
}
__device__ __forceinline__ float sigmoidf_(float x) { return 1.0f / (1.0f + __expf(-x)); }
__device__ __forceinline__ float sigm_fast(float x) { return __builtin_amdgcn_rcpf(1.0f + __expf(-x)); }
__device__ __forceinline__ float gelu_tanh(float x) { const float z = 0.7978845608028654f * (x + 0.044715f * x * x * x); const float t = 1.0f - 2.0f / (__expf(2.0f * z) + 1.0f); return 0.5f * x * (1.0f + t); }
__device__ __forceinline__ float* hrow(float* out, float* hmeta, int r) {
    const int b = r >= RA ? 1 : 0, a = r - b * RA;
    return a >= 256 ? out + ((size_t)(b * SEQ + a - 256) << 10) : hmeta + ((size_t)(b * 256 + a) << 10);
}

#define XB_TMO      128
#define XB_XCNT(j)  (256  + 64 * (j))
#define XB_XSUB(j)  (1280 + 64 * (j))
#define XB_XGEN(j)  (2304 + 64 * (j))
#define XB_TOP      3328
#define XB_TOPGEN   3392
#define XCD_BAR_WORDS 3456
#define XB_SPIN_CAP (1u << 22)
__device__ __forceinline__ unsigned xb_ld(unsigned* p)              { return __hip_atomic_load(p, __ATOMIC_RELAXED, __HIP_MEMORY_SCOPE_AGENT); }
__device__ __forceinline__ unsigned xb_add(unsigned* p, unsigned v) { return __hip_atomic_fetch_add(p, v, __ATOMIC_RELAXED, __HIP_MEMORY_SCOPE_AGENT); }
__device__ __forceinline__ unsigned xb_xcc_id() { return (unsigned)__builtin_amdgcn_s_getreg((3 << 11) | 20) & 0xFu; }
#define XB_SPIN(cond, bar) do { unsigned _sp = 0; while (cond) { __builtin_amdgcn_s_sleep(1); \
    if ((++_sp & 255u) == 0u) { if (xb_ld(&(bar)[XB_TMO])) break; if (_sp > XB_SPIN_CAP) { atomicAdd(&(bar)[XB_TMO], 1u); break; } } } } while (0)
struct XcdBarrier { unsigned* bar; unsigned x; volatile LAS unsigned* st; };
__device__ __forceinline__ XcdBarrier xcd_barrier_post(unsigned* bar, volatile LAS unsigned* st) {
    XcdBarrier b; b.bar = bar; b.x = xb_xcc_id(); b.st = st;
    if (threadIdx.x == 0) (void)xb_add(&bar[XB_XCNT(b.x)], 1u);
    return b;
}
__device__ __forceinline__ void xcd_barrier_complete(unsigned* bar, unsigned x, unsigned& nloc, unsigned& nx) {
    const unsigned G = gridDim.x * gridDim.y * gridDim.z;
    unsigned sum, cnt, mine, sp = 0u;
    for (;;) {
        sum = 0u; cnt = 0u; mine = 0u;
#pragma unroll
        for (unsigned j = 0; j < 16; ++j) { const unsigned c = xb_ld(&bar[XB_XCNT(j)]); sum += c; cnt += (c > 0u) ? 1u : 0u; mine = (j == x) ? c : mine; }
        if (sum == G) break;
        __builtin_amdgcn_s_sleep(1);
        if ((++sp & 255u) == 0u) { if (xb_ld(&bar[XB_TMO])) break; if (sp > XB_SPIN_CAP) { atomicAdd(&bar[XB_TMO], 1u); break; } }
    }
    nloc = mine > 0u ? mine : 1u; nx = cnt > 0u ? cnt : 1u;
}
__device__ __forceinline__ void xcd_barrier(const XcdBarrier& b, const int tid) {
    asm volatile("s_waitcnt vmcnt(0)" ::: "memory");
    __syncthreads();
    if (tid == 0) {
        unsigned* bar = b.bar;
        __builtin_amdgcn_s_waitcnt(0);
        unsigned nloc = b.st[0], nx = b.st[1];
        if (nloc == 0u) { xcd_barrier_complete(bar, b.x, nloc, nx); b.st[0] = nloc; b.st[1] = nx; }
        const unsigned old = xb_add(&bar[XB_XSUB(b.x)], 1u);
        const unsigned gen = old / nloc;
        if (old + 1u == (gen + 1u) * nloc) {
            __builtin_amdgcn_fence(__ATOMIC_RELEASE, "agent");
            asm volatile("s_waitcnt vmcnt(0)" ::: "memory");
            const unsigned og = xb_add(&bar[XB_TOP], 1u);
            const unsigned tg = og / nx;
            if (og + 1u == (tg + 1u) * nx) xb_add(&bar[XB_TOPGEN], 1u);
            else XB_SPIN(xb_ld(&bar[XB_TOPGEN]) == tg, bar);
            __builtin_amdgcn_fence(__ATOMIC_ACQUIRE, "agent");
            xb_add(&bar[XB_XGEN(b.x)], 1u);
            asm volatile("s_waitcnt vmcnt(0)" ::: "memory");
        } else {
            XB_SPIN(xb_ld(&bar[XB_XGEN(b.x)]) == gen, bar);
            __builtin_amdgcn_fence(__ATOMIC_ACQUIRE, "agent");
            asm volatile("s_waitcnt vmcnt(0)" ::: "memory");
        }
    }
    __syncthreads();
}

namespace pg8 {
constexpr int BM = 256, BK = 64, HALF = 128, HTB = HALF * BK * 2, STAGE_BYTES = 8 * HTB, NXCD = 8, WGM = 8;
__host__ __device__ __forceinline__ int lds_byte(int r, int c) { const int st = (r >> 4) * 2 + (c >> 5), rr = r & 15, cc = c & 31, ob = rr * 64 + cc * 2; return st * 1024 + (ob ^ (((ob >> 9) & 1) << 5)); }
__host__ __device__ __forceinline__ void stage_rc(int b, int& R_, int& C) { const int st = b / 1024, sb = b % 1024, swz = sb ^ (((sb >> 9) & 1) << 5); R_ = (st >> 1) * 16 + swz / 64; C = (st & 1) * 32 + (swz % 64) / 2; }
__host__ __device__ __forceinline__ int perm32(int rho) { const int n = rho >> 4, i = rho & 15; return 8 * (i >> 2) + 4 * n + (i & 3); }
struct Unit { int pm, pn; };
struct Gemm { const bf16_t* A; const bf16_t* Bt; int lda, ldb, K; };
struct StaticOrder {
    int nM, nN, nwg, G, c;
    __device__ void init(int M, int N, int G_, int c_) { nM = M / BM; nN = N / BM; nwg = nM * nN; G = G_; c = c_; }
    __device__ bool next(int i, Unit& u) const {
        const long L = (long)i * G + c; if (L >= nwg) return false;
        int wgid = (int)L; { const int q = nwg / NXCD, r = nwg % NXCD, xcd = wgid % NXCD, off = wgid / NXCD; wgid = (xcd < r ? xcd * (q + 1) : r * (q + 1) + (xcd - r) * q) + off; }
        const int nig = WGM * nN, gid = wgid / nig, fm = gid * WGM, gsz = (nM - fm) < WGM ? (nM - fm) : WGM;
        const int pml = fm + ((wgid % nig) % gsz); u.pm = pml + 1 + (pml >> 6);
        u.pn = (wgid % nig) / gsz; return true;
    }
    __device__ __forceinline__ size_t a_off(const Unit&) const { return 0; }
};
struct GroupOrder : StaticOrder {
    __device__ __forceinline__ size_t a_off(const Unit& u) const { return (size_t)(u.pn >> 1) * 256 * 2; }
};

template <class Epi, class Sched>
__device__ __forceinline__ void gemm_phase(LAS unsigned char* lds, const Gemm g, const Sched& S, const Epi& E, const int wid0) {
    const int tid = opaque_tid(wid0), wid = __builtin_amdgcn_readfirstlane(tid >> 6), lane = tid & 63, wr = wid >> 2, wc = wid & 3, fr = lane & 15, fq = lane >> 4;
    int K = g.K; asm volatile("" : "+s"(K));
    const int nt = K / BK;
    unsigned voffA[2], voffB[2];
#pragma unroll
    for (int i = 0; i < 2; ++i) { int R_, C; stage_rc(tid * 16 + i * 8192, R_, C); const int Rb = Epi::PERM ? ((R_ & ~31) + perm32(R_ & 31)) : R_;
        voffA[i] = (unsigned)(R_ * g.lda + C) * 2u; voffB[i] = (unsigned)(Rb * g.ldb + C) * 2u; }
    const size_t kstep = (size_t)(BK * 2);
    const size_t hstepA = (size_t)HALF * g.lda * 2, hstepB = (size_t)HALF * g.ldb * 2;
    const size_t tstepA = 2 * hstepA, tstepB = 2 * hstepB;
    const unsigned ldsw = (unsigned)wid * 1024u;
    const int aoff = lds_byte(wr * 64 + fr, fq * 8), boff = lds_byte(wc * 32 + fr, fq * 8);
#define PG8_SA(b, h) (((b) * 2 + (h)) * HTB)
#define PG8_SB(b, h) ((4 + (b) * 2 + (h)) * HTB)
#define PG8_STAGE(bufoff, gbase, voff) do { _Pragma("unroll") for (int _i = 0; _i < 2; ++_i) \
        __builtin_amdgcn_global_load_lds((const unsigned*)((const char*)(gbase) + (voff)[_i]), (LAS unsigned*)(lds + (bufoff) + ldsw + _i * 8192), 16, 0, 0); } while (0)
#define PG8_LDA(dst, b, h) do { _Pragma("unroll") for (int m = 0; m < 4; ++m) _Pragma("unroll") for (int k = 0; k < 2; ++k) dst[m][k] = *(const LAS bf16x8*)(lds + PG8_SA(b, h) + aoff + m * 2048 + k * 1024); } while (0)
#define PG8_LDB(dst, b, h) do { _Pragma("unroll") for (int n = 0; n < 2; ++n) _Pragma("unroll") for (int k = 0; k < 2; ++k) dst[n][k] = *(const LAS bf16x8*)(lds + PG8_SB(b, h) + boff + n * 2048 + k * 1024); } while (0)
#define PG8_MMA(ai, bj, At, Bt) do { __builtin_amdgcn_s_setprio(1); _Pragma("unroll") for (int m = 0; m < 4; ++m) _Pragma("unroll") for (int n = 0; n < 2; ++n) _Pragma("unroll") for (int k = 0; k < 2; ++k) \
        acc[ai][bj][m][n] = __builtin_amdgcn_mfma_f32_16x16x32_bf16(Bt[n][k], At[m][k], acc[ai][bj][m][n], 0, 0, 0); __builtin_amdgcn_s_setprio(0); } while (0)
#define PG8_WAIT_V(n) asm volatile("s_waitcnt vmcnt(" #n ")" ::: "memory")
#define PG8_WAIT_L(n) asm volatile("s_waitcnt lgkmcnt(" #n ")" ::: "memory")
#define PG8_BAR __builtin_amdgcn_s_barrier()
#define PG8_SCHED __builtin_amdgcn_sched_barrier(0)
    Unit cur, nxt; int ui = 0;
    if (!S.next(0, cur)) return;
    f32x4 acc[2][2][4][2];
#pragma unroll
    for (int a = 0; a < 2; ++a)
#pragma unroll
        for (int b = 0; b < 2; ++b)
#pragma unroll
            for (int m = 0; m < 4; ++m)
#pragma unroll
                for (int n = 0; n < 2; ++n) acc[a][b][m][n] = (f32x4){0.f, 0.f, 0.f, 0.f};
    bf16x8 At[4][2], B0[2][2], B1[2][2];
    const char* cA = (const char*)g.A + (size_t)cur.pm * tstepA + S.a_off(cur); const char* cB = (const char*)g.Bt + (size_t)cur.pn * tstepB;
    PG8_STAGE(PG8_SB(0, 0), cB, voffB); PG8_STAGE(PG8_SB(0, 1), cB + hstepB, voffB); PG8_STAGE(PG8_SA(0, 0), cA, voffA); PG8_STAGE(PG8_SA(0, 1), cA + hstepA, voffA);
    if (wr == 1) PG8_BAR;
    PG8_WAIT_V(2); PG8_BAR;
    PG8_STAGE(PG8_SB(1, 0), cB + kstep, voffB); PG8_STAGE(PG8_SA(1, 0), cA + kstep, voffA); PG8_STAGE(PG8_SB(1, 1), cB + hstepB + kstep, voffB);
    PG8_WAIT_V(6); PG8_BAR;
    for (;;) {
        const bool has_next = S.next(ui + 1, nxt);
        const char* nA = has_next ? (const char*)g.A + (size_t)nxt.pm * tstepA + S.a_off(nxt) : cA; const char* nB = has_next ? (const char*)g.Bt + (size_t)nxt.pn * tstepB : cB;
        for (int t = 0; t < nt; t += 2) {
            const bool last = (t == nt - 2);
            const char* a1 = cA + (size_t)(t + 1) * kstep;
            const char* a2 = last ? nA : cA + (size_t)(t + 2) * kstep; const char* b2 = last ? nB : cB + (size_t)(t + 2) * kstep;
            const char* a3 = a2 + kstep; const char* b3 = b2 + kstep;
            PG8_LDB(B0, 0, 0); PG8_LDB(B1, 0, 1); PG8_SCHED; PG8_LDA(At, 0, 0); PG8_STAGE(PG8_SA(1, 1), a1 + hstepA, voffA);
            PG8_WAIT_V(8); PG8_WAIT_L(0); PG8_BAR; PG8_MMA(0, 0, At, B0); PG8_MMA(0, 1, At, B1); PG8_BAR; PG8_SCHED;
            PG8_LDA(At, 0, 1); PG8_STAGE(PG8_SB(0, 0), b2, voffB); PG8_STAGE(PG8_SB(0, 1), b2 + hstepB, voffB); PG8_STAGE(PG8_SA(0, 0), a2, voffA);
            PG8_WAIT_V(8); PG8_WAIT_L(0); PG8_BAR; PG8_MMA(1, 0, At, B0); PG8_MMA(1, 1, At, B1); PG8_BAR; PG8_SCHED;
            PG8_LDB(B0, 1, 0); PG8_LDB(B1, 1, 1); PG8_SCHED; PG8_LDA(At, 1, 0); PG8_STAGE(PG8_SA(0, 1), a2 + hstepA, voffA);
            PG8_WAIT_V(8); PG8_WAIT_L(0); PG8_BAR; PG8_MMA(0, 0, At, B0); PG8_MMA(0, 1, At, B1); PG8_BAR; PG8_SCHED;
            PG8_LDA(At, 1, 1); PG8_STAGE(PG8_SB(1, 0), b3, voffB); PG8_STAGE(PG8_SB(1, 1), b3 + hstepB, voffB); PG8_STAGE(PG8_SA(1, 0), a3, voffA);
            PG8_WAIT_V(8); PG8_WAIT_L(0); PG8_BAR; PG8_MMA(1, 0, At, B0); PG8_MMA(1, 1, At, B1); PG8_BAR; PG8_SCHED;
        }
        if (wr == 0) PG8_BAR;
        E(acc, cur, wr, wc, fr, fq);
        if (!has_next) break;
#pragma unroll
        for (int a = 0; a < 2; ++a)
#pragma unroll
            for (int b = 0; b < 2; ++b)
#pragma unroll
                for (int m = 0; m < 4; ++m)
#pragma unroll
                    for (int n = 0; n < 2; ++n) acc[a][b][m][n] = (f32x4){0.f, 0.f, 0.f, 0.f};
        cur = nxt; cA = nA; cB = nB; ++ui;
        if (wr == 1) PG8_BAR;
    }
    PG8_WAIT_V(0);
    PG8_BAR;
#undef PG8_SA
#undef PG8_SB
#undef PG8_STAGE
#undef PG8_LDA
#undef PG8_LDB
#undef PG8_MMA
#undef PG8_WAIT_V
#undef PG8_WAIT_L
#undef PG8_BAR
#undef PG8_SCHED
}

struct EpiProj {
    static constexpr bool PERM = true;
    bf16_t* d0; bf16_t* d1; bf16_t* d2; bf16_t* d3; bf16_t* qi; bf16_t* ki; float* wi;
    __device__ __forceinline__ void operator()(const f32x4 (&acc)[2][2][4][2], const Unit& u, int wr, int wc, int fr, int fq) const {
        const int row0 = u.pm * BM + wr * 64 + fr;
#pragma unroll
        for (int bj = 0; bj < 2; ++bj) {
            const int colb = u.pn * BM + bj * HALF + wc * 32 + 8 * fq;
            bf16_t* base; int ld, c; bool isf = false, skip = false;
            if (colb < 4096) { const int t = colb >> 10; base = t == 0 ? d0 : t == 1 ? d1 : t == 2 ? d2 : d3; ld = 1024; c = colb & 1023; }
            else if (colb < 4608) { base = qi; ld = 512; c = colb - 4096; }
            else if (colb < 4672) { base = ki; ld = 64; c = colb - 4608; }
            else if (colb == 4672) { base = nullptr; ld = 8; c = 0; isf = true; }
            else { base = nullptr; ld = 0; c = 0; skip = true; }
            if (skip) continue;
#pragma unroll
            for (int ai = 0; ai < 2; ++ai)
#pragma unroll
                for (int m = 0; m < 4; ++m) { const int row = row0 + ai * HALF + m * 16; const f32x4 v0 = acc[ai][bj][m][0], v1 = acc[ai][bj][m][1];
                    if (isf) { float* p = wi + (size_t)row * 8; *(f32x4*)p = v0; *(f32x4*)(p + 4) = v1; }
                    else { u32x4 w; w.x = cvt_pk_bf16(v0[0], v0[1]); w.y = cvt_pk_bf16(v0[2], v0[3]); w.z = cvt_pk_bf16(v1[0], v1[1]); w.w = cvt_pk_bf16(v1[2], v1[3]);
                        *(u32x4*)(base + (size_t)row * ld + c) = w; } }
        }
    }
};
struct EpiRes {
    static constexpr bool PERM = false;
    float* out; float* hmeta; int dry; long sdelta;
    __device__ __forceinline__ void operator()(const f32x4 (&acc)[2][2][4][2], const Unit& u, int wr, int wc, int fr, int fq) const {
        if (dry) return;
        const int row0 = u.pm * BM + wr * 64 + fr, col0 = u.pn * BM + wc * 32 + 4 * fq;
#pragma unroll
        for (int ai = 0; ai < 2; ++ai)
#pragma unroll
            for (int m = 0; m < 4; ++m) { float* rowp = hrow(out, hmeta, row0 + ai * HALF + m * 16) + col0;
#pragma unroll
                for (int bj = 0; bj < 2; ++bj)
#pragma unroll
                    for (int n = 0; n < 2; ++n) { f32x4* p = (f32x4*)(rowp + bj * HALF + n * 16); *p = *(const f32x4*)((const float*)p + sdelta) + acc[ai][bj][m][n]; } }
    }
};
struct EpiRelu2 {
    static constexpr bool PERM = true;
    bf16_t* O; int ldc;
    __device__ __forceinline__ void operator()(const f32x4 (&acc)[2][2][4][2], const Unit& u, int wr, int wc, int fr, int fq) const {
        const int row0 = u.pm * BM + wr * 64 + fr, col0 = u.pn * BM + wc * 32 + 8 * fq;
#pragma unroll
        for (int ai = 0; ai < 2; ++ai)
#pragma unroll
            for (int m = 0; m < 4; ++m) { bf16_t* rowp = O + (size_t)(row0 + ai * HALF + m * 16) * ldc + col0;
#pragma unroll
                for (int bj = 0; bj < 2; ++bj) { f32x4 v0 = acc[ai][bj][m][0], v1 = acc[ai][bj][m][1];
#pragma unroll
                    for (int j = 0; j < 4; ++j) { const float a = fmaxf(v0[j], 0.f), b = fmaxf(v1[j], 0.f); v0[j] = a * a; v1[j] = b * b; }
                    u32x4 w; w.x = cvt_pk_bf16(v0[0], v0[1]); w.y = cvt_pk_bf16(v0[2], v0[3]); w.z = cvt_pk_bf16(v1[0], v1[1]); w.w = cvt_pk_bf16(v1[2], v1[3]);
                    *(u32x4*)(rowp + bj * HALF) = w; } }
    }
};
struct EpiRGPre {
    static constexpr bool PERM = true;
    bf16_t* PA; bf16_t* PX;
    __device__ __forceinline__ void operator()(const f32x4 (&acc)[2][2][4][2], const Unit& u, int wr, int wc, int fr, int fq) const {
        const int row0 = u.pm * BM + wr * 64 + fr, col0 = (u.pn >> 1) * 256 + wc * 32 + 8 * fq;
        bf16_t* base = (bf16_t*)((char*)PA + ((u.pn & 1) ? (size_t)((const char*)PX - (const char*)PA) : (size_t)0));
#pragma unroll
        for (int ai = 0; ai < 2; ++ai)
#pragma unroll
            for (int m = 0; m < 4; ++m) { bf16_t* rowp = base + (size_t)(row0 + ai * HALF + m * 16) * D + col0;
#pragma unroll
                for (int bj = 0; bj < 2; ++bj) { const f32x4 v0 = acc[ai][bj][m][0], v1 = acc[ai][bj][m][1];
                    u32x4 w; w.x = cvt_pk_bf16(v0[0], v0[1]); w.y = cvt_pk_bf16(v0[2], v0[3]); w.z = cvt_pk_bf16(v1[0], v1[1]); w.w = cvt_pk_bf16(v1[2], v1[3]);
                    *(u32x4*)(rowp + bj * HALF) = w; } }
    }
};
}

template <class Epi>
__device__ __forceinline__ void meta_gemm(LAS unsigned char* lds, const bf16_t* A, int lda, const bf16_t* Bt, int ldb, int N, int K, int wgsplit, int ngroups, const Epi& epi, const int wid0) {
    const int tid = opaque_tid(wid0), lane = tid & 63, wid = __builtin_amdgcn_readfirstlane(tid >> 6), m16 = lane & 15, kq = lane >> 4;
    const int ncg = N / 16, Kw = K / wgsplit, Kv = Kw / NWAVES, ntask = ncg * wgsplit, cpg = ncg / ngroups;
    LAS float* part = (LAS float*)lds;
    for (int task = (int)gridDim.x - 1 - (int)blockIdx.x; task < ntask; task += (int)gridDim.x) {
        const int cg = task % ncg, kc = task / ncg, n0 = cg * 16, grp = cg / cpg, kbase = kc * Kw + wid * Kv;
        const bf16_t* a0 = A + (size_t)(PADF + m16) * lda + (size_t)grp * 256 * (ngroups > 1) + kbase + 8 * kq;
        const bf16_t* a1 = a0 + (size_t)RA * lda;
        const bf16_t* bp = Bt + (size_t)(n0 + m16) * ldb + kbase + 8 * kq;
        f32x4 acc0 = {0.f, 0.f, 0.f, 0.f}, acc1 = {0.f, 0.f, 0.f, 0.f};
#pragma unroll 4
        for (int k0 = 0; k0 < Kv; k0 += 32) {
            const bf16x8 fa0 = *(const bf16x8*)(a0 + k0), fa1 = *(const bf16x8*)(a1 + k0), fb = *(const bf16x8*)(bp + k0);
            acc0 = __builtin_amdgcn_mfma_f32_16x16x32_bf16(fa0, fb, acc0, 0, 0, 0);
            acc1 = __builtin_amdgcn_mfma_f32_16x16x32_bf16(fa1, fb, acc1, 0, 0, 0);
        }
        *(LAS f32x4*)(part + (wid * 64 + lane) * 8) = acc0; *(LAS f32x4*)(part + (wid * 64 + lane) * 8 + 4) = acc1;
        __syncthreads();
        {
            const int m = tid >> 4, n = tid & 15, src = ((((m & 15) >> 2) * 16 + n) * 8) + (m >> 4) * 4 + (m & 3);
            float v = 0.f;
#pragma unroll
            for (int w = 0; w < NWAVES; ++w) v += part[w * 512 + src];
            epi((m >> 4) * RA + PADF + (m & 15), n0 + n, v);
        }
        __syncthreads();
    }
}
struct MEpiProj { bf16_t* d0; bf16_t* d1; bf16_t* d2; bf16_t* d3; bf16_t* qi; bf16_t* ki; float* wi;
    __device__ __forceinline__ void operator()(int row, int col, float v) const {
        if (col < 4096) { const int t = col >> 10; bf16_t* base = t == 0 ? d0 : t == 1 ? d1 : t == 2 ? d2 : d3; base[(size_t)row * 1024 + (col & 1023)] = (bf16_t)(cvt_pk_bf16(v, 0.f) & 0xffffu); }
        else if (col < 4608) qi[(size_t)row * 512 + (col - 4096)] = (bf16_t)(cvt_pk_bf16(v, 0.f) & 0xffffu);
        else if (col < 4672) ki[(size_t)row * 64 + (col - 4608)] = (bf16_t)(cvt_pk_bf16(v, 0.f) & 0xffffu);
        else if (col < 4680) wi[(size_t)row * 8 + (col - 4672)] = v;
    } };
struct MEpiRG { bf16_t* PA; bf16_t* PX;
    __device__ __forceinline__ void operator()(int row, int col, float v) const { const int g = col >> 9, c = col & 511; bf16_t* base = (bf16_t*)((char*)PA + ((c & 256) ? (size_t)((const char*)PX - (const char*)PA) : (size_t)0)); base[(size_t)row * 1024 + g * 256 + (c & 255)] = (bf16_t)(cvt_pk_bf16(v, 0.f) & 0xffffu); } };
struct MEpiRes { float* out; float* hmeta;
    __device__ __forceinline__ void operator()(int row, int col, float v) const { atomicAdd(hrow(out, hmeta, row) + col, v); } };
struct MEpiRelu2 { bf16_t* O;
    __device__ __forceinline__ void operator()(int row, int col, float v) const { const float a = fmaxf(v, 0.f); O[(size_t)row * FF + col] = (bf16_t)(cvt_pk_bf16(a * a, 0.f) & 0xffffu); } };

struct Args {
    const float* x; const float* norm1_g; const float* w_in; const float* conv_w; const float* conv_b;
    const float* w_rg_a; const float* b_rg_a; const float* w_rg_x; const float* b_rg_x; const float* lru_lambda;
    const float* w_out; const float* norm2_g; const float* w_mlp1; const float* w_mlp2; const float* rel_bias;
    const float* meta; const float* final_g; float* out; unsigned char* ws; int ph_lo, ph_hi;
};

__device__ __forceinline__ void transpose_item(const float* W, int ldw, int K, int kb, int src_col0, int nvalid, bf16_t* WT, int dst_row0, int dst_stride, LAS float* scr, int lane, const float wscale = 1.0f) {
    const int k0 = 64 * kb, c4 = (lane & 7) * 4;
    f32x4 ld[8];
#pragma unroll
    for (int i = 0; i < 8; ++i) { const int kk = (lane >> 3) + 8 * i; ld[i] = (c4 < nvalid) ? *(const f32x4*)(W + (size_t)(k0 + kk) * ldw + src_col0 + c4) : (f32x4){0.f, 0.f, 0.f, 0.f}; }
#pragma unroll
    for (int i = 0; i < 8; ++i) { const int kk = (lane >> 3) + 8 * i;
#pragma unroll
        for (int j = 0; j < 4; ++j) scr[kk * 33 + c4 + j] = ld[i][j] * wscale; }
    asm volatile("s_waitcnt lgkmcnt(0)" ::: "memory");
    const int c8 = lane & 7;
#pragma unroll
    for (int j = 0; j < 4; ++j) { const int n = (lane >> 3) + 8 * j; const LAS float* s = scr + (8 * c8) * 33 + n;
        u32x4 o; o.x = cvt_pk_bf16(s[0 * 33], s[1 * 33]); o.y = cvt_pk_bf16(s[2 * 33], s[3 * 33]); o.z = cvt_pk_bf16(s[4 * 33], s[5 * 33]); o.w = cvt_pk_bf16(s[6 * 33], s[7 * 33]);
        *(u32x4*)(WT + (size_t)(dst_row0 + n * dst_stride) * K + k0 + 8 * c8) = o; }
    asm volatile("s_waitcnt lgkmcnt(0)" ::: "memory");
}
__device__ __forceinline__ int win_src(int drow, int& nvalid) {
    nvalid = 32;
    if (drow < 2048) return drow;
    if (drow < 3072) return 5704 + (drow - 2048);
    const int j = drow - 3072;
    if (j < 1024) return 2048 + j;
    if (j < 2048) return 3072 + (j - 1024);
    if (j < 3072) return 4096 + (j - 2048);
    if (j < 4096) return 6728 + (j - 3072);
    if (j < 4608) return 5120 + (j - 4096);
    if (j < 4672) return 5632 + (j - 4608);
    if (j == 4672) { nvalid = 8; return 5696; }
    nvalid = 0; return 0;
}
__device__ __forceinline__ int t5_bucket(int d) {
    if (d < 16) return d;
    int v = 16 + (int)(logf((float)d / 16.0f) / logf(8.0f) * 16.0f);
    return v > 31 ? 31 : v;
}
__device__ __forceinline__ void phase_prologue(const Args& A, LAS unsigned char* lds, const int wid0) {
    const int tid = opaque_tid(wid0), lane = tid & 63, wave = __builtin_amdgcn_readfirstlane(tid >> 6), gw = blockIdx.x * NWAVES + wave, NGW = gridDim.x * NWAVES;
    LAS float* scr = (LAS float*)(lds + wave * 16384);
    constexpr int I_IN = (WIN_ROWS / 32) * 16, I_OUT = 32 * 16, I_1 = 128 * 16, I_2 = 32 * 64, I_RG = 2 * 4 * 8 * 4, I_L = I_IN + I_OUT + I_1 + I_2 + I_RG;
    for (int it = gw; it < DEPTH * I_L; it += NGW) {
        const int l = it / I_L; int r = it - l * I_L;
        if (r < I_IN) { const int rb = r >> 4, kb = r & 15; int nv; const int sc = win_src(rb * 32, nv);
            transpose_item(A.w_in + (size_t)l * D * NIN, NIN, D, kb, sc, nv, (bf16_t*)(A.ws + WS_WIN + (size_t)l * 16 * MiB), rb * 32, 1, scr, lane, (rb >= 96 && rb < 128) ? 0.12751743f : 1.0f); continue; }
        r -= I_IN;
        if (r < I_OUT) { transpose_item(A.w_out + (size_t)l * D * D, D, D, r & 15, (r >> 4) * 32, 32, (bf16_t*)(A.ws + WS_WOUT + (size_t)l * 2 * MiB), (r >> 4) * 32, 1, scr, lane); continue; }
        r -= I_OUT;
        if (r < I_1) { transpose_item(A.w_mlp1 + (size_t)l * D * FF, FF, D, r & 15, (r >> 4) * 32, 32, (bf16_t*)(A.ws + WS_W1 + (size_t)l * 8 * MiB), (r >> 4) * 32, 1, scr, lane); continue; }
        r -= I_1;
        if (r < I_2) { transpose_item(A.w_mlp2 + (size_t)l * FF * D, D, FF, r & 63, (r >> 6) * 32, 32, (bf16_t*)(A.ws + WS_W2 + (size_t)l * 8 * MiB), (r >> 6) * 32, 1, scr, lane); continue; }
        r -= I_2;
        { const int mat = r >> 7, g = (r >> 5) & 3, nb = (r >> 2) & 7, kb = r & 3;
          const float* W = (mat ? A.w_rg_x : A.w_rg_a) + ((size_t)l * 4 + g) * 65536;
          transpose_item(W, 256, 256, kb, nb * 32, 32, (bf16_t*)(A.ws + WS_WRG + (size_t)l * MiB) + (size_t)g * 512 * 256, mat * 256 + nb * 32, 1, scr, lane); }
    }
    if (gw == 0) {
        float* lut = (float*)(A.ws + WS_LUT);
        for (int i = lane; i < NH * 128; i += 64) { const int h = i >> 7, d = i & 127;
            lut[i] = (A.rel_bias[t5_bucket(d) * NH + h] - A.rel_bias[31 * NH + h]) * 1.4426950408889634f; }
    }
}

template <int MODE>
__device__ __forceinline__ void phase_rmsnorm(const Args& A, const float* gain, bf16_t* XN, const int wid0, bf16_t* Z0 = nullptr, bf16_t* Z1 = nullptr) {
    const int tid = opaque_tid(wid0), lane = tid & 63, wave = __builtin_amdgcn_readfirstlane(tid >> 6), gw = blockIdx.x * NWAVES + wave, NGW = gridDim.x * NWAVES;
    if (Z0) {
        for (int i = gw; i < 2 * NB * 48; i += NGW) { bf16_t* base = (i & 1) ? Z1 : Z0; const int rr = i >> 1, b = rr / 48, a = 192 + rr % 48; u32x2* o = (u32x2*)(base + ((size_t)b * RA + a) * D) + lane;
#pragma unroll
            for (int j = 0; j < 4; ++j) o[64 * j] = (u32x2){0u, 0u}; } }
    float* hmeta = (float*)(A.ws + WS_HMETA);
    f32x4 gv[4];
#pragma unroll
    for (int j = 0; j < 4; ++j) gv[j] = *((const f32x4*)gain + lane + 64 * j);
    for (int row0 = gw; row0 < R; row0 += 2 * NGW) {
        f32x4 v[2][4]; bool act[2] = {false, false}; float* hp[2] = {nullptr, nullptr};
#pragma unroll
        for (int rr = 0; rr < 2; ++rr) {
            const int row = row0 + rr * NGW;
            if (row >= R) continue;
            const int b = row >= RA ? 1 : 0, a = row - b * RA;
            if (a < PADF) {
                if (MODE != 2) { u32x2* o = (u32x2*)(XN + (size_t)row * D) + lane;
#pragma unroll
                    for (int j = 0; j < 4; ++j) o[64 * j] = (u32x2){0u, 0u}; }
                if (MODE == 0) { f32x4* hz = (f32x4*)hrow(A.out, hmeta, row) + lane;
#pragma unroll
                    for (int j = 0; j < 4; ++j) hz[64 * j] = (f32x4){0.f, 0.f, 0.f, 0.f}; }
                continue;
            }
            if (MODE == 2 && a < 256) continue;
            act[rr] = true; hp[rr] = hrow(A.out, hmeta, row);
            const float* src = hp[rr];
            if (MODE == 0) src = (a < 256) ? A.meta + (size_t)(a - PADF) * D : A.x + ((size_t)(b * SEQ + a - 256) << 10);
#pragma unroll
            for (int j = 0; j < 4; ++j) v[rr][j] = *((const f32x4*)src + lane + 64 * j);
        }
#pragma unroll
        for (int rr = 0; rr < 2; ++rr) {
            if (!act[rr]) continue;
            const int row = row0 + rr * NGW;
            float s = 0.f;
#pragma unroll
            for (int j = 0; j < 4; ++j) s += (v[rr][j].x * v[rr][j].x + v[rr][j].y * v[rr][j].y) + (v[rr][j].z * v[rr][j].z + v[rr][j].w * v[rr][j].w);
            const float rstd = 1.0f / sqrtf(wave_sum(s) * (1.0f / D) + EPS);
            if (MODE == 0 && row - (row >= RA ? RA : 0) < 256) {
#pragma unroll
                for (int j = 0; j < 4; ++j) *((f32x4*)hp[rr] + lane + 64 * j) = v[rr][j]; }
            if (MODE == 2) {
#pragma unroll
                for (int j = 0; j < 4; ++j) *((f32x4*)hp[rr] + lane + 64 * j) = v[rr][j] * rstd * gv[j];
            } else {
                u32x2* o = (u32x2*)(XN + (size_t)row * D) + lane;
#pragma unroll
                for (int j = 0; j < 4; ++j) { const f32x4 y = v[rr][j] * rstd * gv[j]; o[64 * j] = (u32x2){cvt_pk_bf16(y.x, y.y), cvt_pk_bf16(y.z, y.w)}; }
            }
        }
    }
}

__device__ __forceinline__ void phase_conv(const bf16_t* U, bf16_t* XC, const float* cw, const float* cb, int G, const int wid0) {
    const int t_ = opaque_tid(wid0), ch = (t_ & 255) * 4, us = t_ >> 8;
    f32x4 w[4];
#pragma unroll
    for (int j = 0; j < 4; ++j) w[j] = *(const f32x4*)(cw + j * D + ch);
    const f32x4 bb = *(const f32x4*)(cb + ch);
    for (int unit = blockIdx.x * 2 + us; unit < NB * NCHUNK; unit += 2 * G) {
        const int b = unit / NCHUNK, c = unit - b * NCHUNK; const size_t r0 = (size_t)b * RA + c * CHROWS;
        f32x4 x0 = {0.f, 0.f, 0.f, 0.f}, x1 = x0, x2 = x0;
        if (c * CHROWS - 3 >= PADF) { const u32x2 q = *(const u32x2*)(U + (r0 - 3) * D + ch); x0 = (f32x4){bf_lo(q.x), bf_hi(q.x), bf_lo(q.y), bf_hi(q.y)}; }
        if (c * CHROWS - 2 >= PADF) { const u32x2 q = *(const u32x2*)(U + (r0 - 2) * D + ch); x1 = (f32x4){bf_lo(q.x), bf_hi(q.x), bf_lo(q.y), bf_hi(q.y)}; }
        if (c * CHROWS - 1 >= PADF) { const u32x2 q = *(const u32x2*)(U + (r0 - 1) * D + ch); x2 = (f32x4){bf_lo(q.x), bf_hi(q.x), bf_lo(q.y), bf_hi(q.y)}; }
#pragma unroll 5
        for (int i = 0; i < CHROWS; ++i) {
            const size_t off = (r0 + i) * D + ch;
            const bool live = c * CHROWS + i >= PADF;
            f32x4 x3 = {0.f, 0.f, 0.f, 0.f};
            if (live) { const u32x2 q = *(const u32x2*)(U + off); x3 = (f32x4){bf_lo(q.x), bf_hi(q.x), bf_lo(q.y), bf_hi(q.y)}; }
            const f32x4 acc = bb + w[0] * x0 + w[1] * x1 + w[2] * x2 + w[3] * x3;
            u32x2 o = {0u, 0u};
            if (live) { o.x = cvt_pk_bf16(acc.x, acc.y); o.y = cvt_pk_bf16(acc.z, acc.w); }
            *(u32x2*)(XC + off) = o;
            x0 = x1; x1 = x2; x2 = x3;
        }
    }
}

__device__ __forceinline__ float nexpm1_fast(float x) {
    const float e = 1.0f - __expf(x), p = -x * (1.0f + x * (0.5f + x * 0.16666667f));
    return x > -0.01f ? p : e;
}
__device__ __forceinline__ void phase_scan_local(bf16_t* PA, bf16_t* PX, const bf16_t* XC, const float* ba, const float* bx, const float* lam, float* AGG, int G, const bool dry, const int wid0) {
    const int t_ = opaque_tid(wid0), ch = (t_ & 255) * 4, us = t_ >> 8;
    const f32x4 bav = *(const f32x4*)(ba + ch), bxv = *(const f32x4*)(bx + ch), lmv = *(const f32x4*)(lam + ch);
    float sp[4];
#pragma unroll
    for (int k = 0; k < 4; ++k) sp[k] = -8.0f * log1pf(__expf(-lmv[k]));
    for (int unit = blockIdx.x * 2 + us; unit < NB * NCHUNK; unit += 2 * G) {
        const int b = unit / NCHUNK, c = unit - b * NCHUNK; const size_t r0 = (size_t)b * RA + c * CHROWS;
        float Ac[4] = {1.f, 1.f, 1.f, 1.f}, Hc[4] = {0.f, 0.f, 0.f, 0.f};
#pragma unroll 5
        for (int i = 0; i < CHROWS; ++i) {
            const size_t off = (r0 + i) * D + ch;
            const u32x2 pa = *(const u32x2*)(PA + off), px = *(const u32x2*)(PX + off), xc = *(const u32x2*)(XC + off);
            float l[4], v[4];
            l[0] = sigm_fast(bf_lo(pa.x) + bav[0]) * sp[0]; l[1] = sigm_fast(bf_hi(pa.x) + bav[1]) * sp[1]; l[2] = sigm_fast(bf_lo(pa.y) + bav[2]) * sp[2]; l[3] = sigm_fast(bf_hi(pa.y) + bav[3]) * sp[3];
            v[0] = sigm_fast(bf_lo(px.x) + bxv[0]) * bf_lo(xc.x); v[1] = sigm_fast(bf_hi(px.x) + bxv[1]) * bf_hi(xc.x); v[2] = sigm_fast(bf_lo(px.y) + bxv[2]) * bf_lo(xc.y); v[3] = sigm_fast(bf_hi(px.y) + bxv[3]) * bf_hi(xc.y);
            if (c * CHROWS + i < PADF) {
#pragma unroll
                for (int k = 0; k < 4; ++k) { l[k] = 0.f; v[k] = 0.f; } }
            h16x4 lh, vh;
#pragma unroll
            for (int k = 0; k < 4; ++k) { lh[k] = (_Float16)l[k]; vh[k] = (_Float16)v[k]; }
            if (!dry) { *(h16x4*)(PA + off) = lh; *(h16x4*)(PX + off) = vh; }
#pragma unroll
            for (int k = 0; k < 4; ++k) { const float lr = (float)lh[k], vr = (float)vh[k];
                const float ak = __expf(lr); Hc[k] = ak * Hc[k] + __builtin_amdgcn_sqrtf(nexpm1_fast(2.0f * lr)) * vr; Ac[k] *= ak; }
        }
        if (!dry) { *(f32x4*)(AGG + (size_t)unit * D + ch) = (f32x4){Ac[0], Ac[1], Ac[2], Ac[3]};
            *(f32x4*)(AGG + (size_t)(NB * NCHUNK + unit) * D + ch) = (f32x4){Hc[0], Hc[1], Hc[2], Hc[3]}; }
    }
}
__device__ __forceinline__ void phase_scan_carry(const float* AGG, float* CARRY, const int wid0) {
    const int tid = opaque_tid(wid0), lane = tid & 63, wave = __builtin_amdgcn_readfirstlane(tid >> 6), gw = blockIdx.x * NWAVES + wave, NGW = gridDim.x * NWAVES;
    for (int t = gw; t < NB * D; t += NGW) {
        const int b = t >> 10, ch = t & 1023;
        float a[4], hh[4];
#pragma unroll
        for (int i = 0; i < 4; ++i) { const size_t u = (size_t)(b * NCHUNK + 4 * lane + i); a[i] = AGG[u * D + ch]; hh[i] = AGG[((size_t)NB * NCHUNK + u) * D + ch]; }
        float Am = a[0], Bm = hh[0];
#pragma unroll
        for (int i = 1; i < 4; ++i) { Bm = a[i] * Bm + hh[i]; Am *= a[i]; }
#pragma unroll
        for (int off = 1; off < 64; off <<= 1) { const float Ap = __shfl_up(Am, off), Bp = __shfl_up(Bm, off); if (lane >= off) { Bm = Am * Bp + Bm; Am = Am * Ap; } }
        float h = __shfl_up(Bm, 1); if (lane == 0) h = 0.f;
#pragma unroll
        for (int i = 0; i < 4; ++i) { CARRY[(size_t)(b * NCHUNK + 4 * lane + i) * D + ch] = h; h = a[i] * h + hh[i]; }
    }
}
__device__ __forceinline__ float gelu_fast(float x) { const float z = 0.7978845608028654f * (x + 0.044715f * x * x * x); return x * __builtin_amdgcn_rcpf(1.0f + __expf(-2.0f * z)); }
__device__ __forceinline__ void phase_scan_apply(const _Float16* LA, const _Float16* V, const float* CARRY, const bf16_t* UG, const bf16_t* GR, bf16_t* Y, int G, const int wid0) {
    const int t_ = opaque_tid(wid0), ch = (t_ & 255) * 4, us = t_ >> 8;
    for (int unit = blockIdx.x * 2 + us; unit < NB * NCHUNK; unit += 2 * G) {
        const int b = unit / NCHUNK, c = unit - b * NCHUNK; const size_t r0 = (size_t)b * RA + c * CHROWS;
        const f32x4 hc = *(const f32x4*)(CARRY + (size_t)unit * D + ch);
        float Hc[4] = {hc.x, hc.y, hc.z, hc.w};
#pragma unroll 5
        for (int i = 0; i < CHROWS; ++i) {
            const size_t off = (r0 + i) * D + ch;
            const h16x4 la = *(const h16x4*)(LA + off), vv = *(const h16x4*)(V + off);
            const u32x2 ug = *(const u32x2*)(UG + off), gr = *(const u32x2*)(GR + off);
            const float ugf[4] = {bf_lo(ug.x), bf_hi(ug.x), bf_lo(ug.y), bf_hi(ug.y)}, grf[4] = {bf_lo(gr.x), bf_hi(gr.x), bf_lo(gr.y), bf_hi(gr.y)};
            float y[4];
#pragma unroll
            for (int k = 0; k < 4; ++k) { const float lr = (float)la[k]; const float ak = __expf(lr);
                Hc[k] = ak * Hc[k] + __builtin_amdgcn_sqrtf(nexpm1_fast(2.0f * lr)) * (float)vv[k];
                y[k] = Hc[k] * gelu_fast(ugf[k]) * sigm_fast(grf[k]); }
            if (c * CHROWS + i < PADF) { y[0] = 0.f; y[1] = 0.f; y[2] = 0.f; y[3] = 0.f; }
            *(u32x2*)(Y + off) = (u32x2){cvt_pk_bf16(y[0], y[1]), cvt_pk_bf16(y[2], y[3])};
        }
    }
}


constexpr int IDX_KBUF = 65536, IDX_TAB = 131072, IDX_CAP = 16, IDX_DB = 9, IDX_OVF = 2048, IDX_TMP = 1024;
__device__ __forceinline__ unsigned mono_key(float s) { const unsigned v = __float_as_uint(s); return v ^ ((unsigned)((int)v >> 31) | 0x80000000u); }
__device__ __forceinline__ unsigned qb_bin(float v) { const unsigned bits = __float_as_uint(v); int f = (int)((bits >> 21) & 0x3ffu) - 444; f = f < 0 ? 0 : (f > 255 ? 255 : f); return (bits >> 31) ? (unsigned)(255 - f) : (unsigned)(256 + f); }
__device__ __forceinline__ float qb_edge(int f) { return f <= 0 ? 0.f : __uint_as_float((unsigned)(f + 444) << 21); }
__device__ __forceinline__ float qb_lo(unsigned b) { return b >= 256u ? qb_edge((int)b - 256) : -qb_edge(256 - (int)b); }
__device__ __forceinline__ float qb_hi(unsigned b) { return b >= 256u ? qb_edge((int)b - 255) : -qb_edge(255 - (int)b); }
__device__ __forceinline__ float inv_mono_key(unsigned k) { return __uint_as_float((k & 0x80000000u) ? (k ^ 0x80000000u) : ~k); }
__device__ __forceinline__ float bin_threshold(float target, float wsc, float wof) {
    unsigned k = mono_key((target - wof) / wsc);
    for (int i = 0; i < 64 && fmaf(inv_mono_key(k - 1u), wsc, wof) >= target; ++i) --k;
    for (int i = 0; i < 64 && !(fmaf(inv_mono_key(k), wsc, wof) >= target); ++i) ++k;
    return inv_mono_key(k);
}
__device__ __forceinline__ unsigned long long* mask_chunk(unsigned long long* MASK, int b, int qblk, int j) { return MASK + ((size_t)b * MASK_CHUNKS_PER_BATCH + 2 * qblk * (qblk + 1) + j) * 256; }

constexpr int IDX_WB = 256;
template <int MODE>
__device__ __forceinline__ void idx_sweep(LAS unsigned char* lds, const bf16_t* KIb, const bf16x8 (&qf)[8][2], const bf16x8 (&qs)[2][2], const float (&cs)[8], const int u, const int tid, const unsigned pfx, const int a_q, const unsigned Wq, unsigned long long* mrow, const int stride, const int shift, const float wlo, const float whi, const float wsc, const float wof, unsigned long long* gbuf) {
    const int lane = tid & 63, wid = __builtin_amdgcn_readfirstlane(tid >> 6), q16 = lane & 15, g = lane >> 4, qg = wid & 3, ksp = wid >> 2;
    const int nsteps = (u >> 2) + 1;
    const bf16_t* gsrc = KIb + (size_t)(tid >> 3) * IDIM + (((tid & 7) ^ ((tid >> 4) & 7)) << 3);
    LAS unsigned char* kb = lds + IDX_KBUF;
    const unsigned dma_off = (unsigned)wid * 1024u;
    const int sw = (q16 >> 1) & 7;
    const int kaddr0 = q16 * 128 + ((g ^ sw) << 4), kaddr1 = q16 * 128 + (((g + 4) ^ sw) << 4);
    LAS unsigned* hist = (LAS unsigned*)lds;
    const int qrow = 16 * qg + q16, hrow_ = qrow * 256, hx = qrow & 31;
    unsigned ccount = 0u; const int csub = qrow * 8 + ksp * 4 + g;
    unsigned above = 0u;
    float f_lo = 0.f, f_hi = 0.f;
    if (MODE == 4) { if (pfx == 0xFFFFFFFFu) { f_hi = -3.402823466e38f; f_lo = f_hi; } else { f_lo = inv_mono_key(pfx << shift); f_hi = inv_mono_key((pfx + 1u) << shift); } }
    float t_sel = -3.402823466e38f, t_cand = -3.402823466e38f;
    if (MODE == 7 && wsc > 0.f) { t_cand = bin_threshold((float)((int)pfx + 1), wsc, wof); t_sel = bin_threshold((float)((int)pfx + 2), wsc, wof); }
#pragma unroll
    for (int i = 0; i < 4; ++i) __builtin_amdgcn_global_load_lds((const unsigned*)(gsrc + (size_t)(64 * i) * IDIM), (LAS unsigned*)(kb + i * 8192 + dma_off), 16, 0, 0);
    asm volatile("s_waitcnt vmcnt(0)" ::: "memory");
    __syncthreads();
    for (int s = 0, it = 0; s < nsteps; s += stride, ++it) {
        const bool more = s + stride < nsteps;
        if (more) {
#pragma unroll
            for (int i = 0; i < 4; ++i) __builtin_amdgcn_global_load_lds((const unsigned*)(gsrc + (size_t)(256 * (s + stride) + 64 * i) * IDIM), (LAS unsigned*)(kb + ((it + 1) & 1) * 32768 + i * 8192 + dma_off), 16, 0, 0); }
#pragma unroll
        for (int tt = 0; tt < 2; ++tt) {
            const int t = 4 * s + 2 * ksp + tt;
            const LAS unsigned char* kt = kb + (it & 1) * 32768 + (2 * ksp + tt) * 8192;
            if (t >= 3 && t <= u) {
                const bool edge = (t == u) || (t == 3);
                f32x4 sc[4];
                {
                    bf16x8 kf[4][2];
#pragma unroll
                    for (int bk = 0; bk < 4; ++bk) { kf[bk][0] = *(const LAS bf16x8*)(kt + kaddr0 + bk * 2048); kf[bk][1] = *(const LAS bf16x8*)(kt + kaddr1 + bk * 2048); }
                    const f32x4 z4 = {0.f, 0.f, 0.f, 0.f};
                    f32x4 a_cur = __builtin_amdgcn_mfma_f32_16x16x32_bf16(kf[0][0], qs[0][0], z4, 0, 0, 0), a_done = z4, sv = z4;
#pragma unroll
                    for (int j = 0; j <= 36; ++j) {
                        f32x4 a_nxt = z4, b_ = z4;
                        if (j < 36) {
                            if (j + 1 < 36) { const int bk1 = (j + 1) / 9, j1 = (j + 1) % 9; a_nxt = __builtin_amdgcn_mfma_f32_16x16x32_bf16(kf[bk1][0], j1 == 0 ? qs[0][0] : qf[j1 == 0 ? 0 : j1 - 1][0], z4, 0, 0, 0); }
                            const int bk = j / 9, jj = j % 9;
                            b_ = __builtin_amdgcn_mfma_f32_16x16x32_bf16(kf[bk][1], jj == 0 ? qs[0][1] : qf[jj == 0 ? 0 : jj - 1][1], a_cur, 0, 0, 0);
                        }
                        __builtin_amdgcn_sched_barrier(0);
                        if (j >= 1) { const int bkp = (j - 1) / 9, jp = (j - 1) % 9;
                            if (jp == 0) sv = a_done;
                            else {
#pragma unroll
                                for (int r = 0; r < 4; ++r) { sv[r] = fmaf(__builtin_fabsf(a_done[r]), cs[jp - 1], sv[r]); asm volatile("" : "+v"(sv[r])); }
                            }
                            if (jp == 8) sc[bkp] = sv; }
                        __builtin_amdgcn_sched_barrier(0);
                        a_done = b_; a_cur = a_nxt;
                    }
                }
                if (edge) {
                    const int dq = a_q - 64 * t - 4 * g;
#pragma unroll
                    for (int bk = 0; bk < 4; ++bk)
#pragma unroll
                        for (int r = 0; r < 4; ++r) { if ((unsigned)(dq - (16 * bk + r)) >= Wq) sc[bk][r] = -__builtin_inff(); }
                }
                if (MODE == 6) {
                    const unsigned rb = (unsigned)(uintptr_t)(hist + hrow_) - 4u; unsigned one_ = 1u; asm volatile("" : "+v"(one_));
#pragma unroll
                    for (int bk = 0; bk < 4; ++bk)
#pragma unroll
                        for (int r = 0; r < 4; ++r) { int t = (int)fmaf(sc[bk][r], wsc, wof); t = t < IDX_WB ? t : IDX_WB;
                            const unsigned addr = ((unsigned)t << 2) + rb;
                            unsigned long long sv_;
                            asm volatile("v_cmp_lt_i32 vcc, 0, %2\n\ts_and_saveexec_b64 %0, vcc\n\tds_add_u32 %1, %3\n\ts_mov_b64 exec, %0" : "=&s"(sv_) : "v"(addr), "v"(t), "v"(one_) : "vcc", "memory");
                        }
                } else if (MODE == 5) {
#pragma unroll
                    for (int bk = 0; bk < 4; ++bk)
#pragma unroll
                        for (int r = 0; r < 4; ++r) { const unsigned bin = qb_bin(sc[bk][r]);
                            __hip_atomic_fetch_add(hist + hrow_ + ((bin >> 1) ^ hx), (bin & 1u) ? 65536u : 1u, __ATOMIC_RELAXED, __HIP_MEMORY_SCOPE_WORKGROUP); }
                } else if (MODE < 3) {
#pragma unroll
                    for (int bk = 0; bk < 4; ++bk)
#pragma unroll
                        for (int r = 0; r < 4; ++r) {
                            const unsigned key = mono_key(sc[bk][r]);
                            const bool match = (MODE == 0) ? true : ((key >> ((32 - IDX_DB * MODE) & 31)) == pfx);
                            if (match) { const unsigned bin = (key >> (32 - IDX_DB - IDX_DB * MODE)) & 511u;
                                __hip_atomic_fetch_add(hist + hrow_ + ((bin >> 1) ^ hx), (bin & 1u) ? 65536u : 1u, __ATOMIC_RELAXED, __HIP_MEMORY_SCOPE_WORKGROUP); }
                        }
                } else {
                    unsigned wlo_ = 0u, whi_ = 0u;
                    if (MODE == 3) {
#pragma unroll
                        for (int bk = 0; bk < 4; ++bk)
#pragma unroll
                            for (int r = 0; r < 4; ++r) { if (mono_key(sc[bk][r]) >= pfx) { if (bk < 2) wlo_ |= 1u << (16 * bk + r); else whi_ |= 1u << (16 * (bk - 2) + r); } }
                    } else {
                        unsigned cm = 0u;
#pragma unroll
                        for (int bk = 0; bk < 4; ++bk)
#pragma unroll
                            for (int r = 0; r < 4; ++r) { const float v = sc[bk][r];
                                if (MODE == 7) continue;
                                const bool selv = v >= f_hi, candv = !selv && v >= f_lo;
                                if (selv) { if (bk < 2) wlo_ |= 1u << (16 * bk + r); else whi_ |= 1u << (16 * (bk - 2) + r); }
                                else if (candv) cm |= 1u << (4 * bk + r); }
                        if (MODE == 7) {
                            unsigned selw = 0u; const int p1 = (int)pfx + 1;
#pragma unroll
                            for (int e = 15; e >= 0; --e)
                                asm volatile("v_cmp_ge_f32 vcc, %2, %3\n\tv_addc_co_u32 %0, vcc, %0, %0, vcc\n\tv_cmp_ge_f32 vcc, %2, %4\n\tv_addc_co_u32 %1, vcc, %1, %1, vcc" : "+v"(selw), "+v"(cm) : "v"(sc[e >> 2][e & 3]), "v"(t_sel), "v"(t_cand) : "vcc");
                            cm &= ~selw; (void)p1;
                            wlo_ = (selw & 0xFu) | ((selw & 0xF0u) << 12); whi_ = ((selw >> 8) & 0xFu) | ((selw & 0xF000u) << 4);
                        }
                        if (__any(cm != 0u)) {
                            LAS unsigned long long* clist = (LAS unsigned long long*)lds + (size_t)csub * IDX_CAP;
#pragma unroll
                            for (int bk = 0; bk < 4; ++bk) { if (__any((cm >> (4 * bk)) & 15u)) {
#pragma unroll
                                for (int r = 0; r < 4; ++r) { if (cm & (1u << (4 * bk + r))) {
                                    const unsigned long long e_ = ((unsigned long long)__float_as_uint(sc[bk][r]) << 32) | (unsigned)(64 * t + 16 * bk + 4 * g + r);
                                    if (ccount < (unsigned)IDX_CAP) clist[ccount] = e_;
                                    else { const unsigned sl = __hip_atomic_fetch_add((LAS unsigned*)(lds + IDX_TAB) + 195, 1u, __ATOMIC_RELAXED, __HIP_MEMORY_SCOPE_WORKGROUP);
                                        if (sl < (unsigned)IDX_OVF) { gbuf[2 * sl] = (unsigned long long)qrow; gbuf[2 * sl + 1] = e_; } }
                                    ++ccount; } } } }
                        }
                    }
                    wlo_ <<= 4 * g; whi_ <<= 4 * g;
                    wlo_ |= __shfl_xor(wlo_, 16); whi_ |= __shfl_xor(whi_, 16); wlo_ |= __shfl_xor(wlo_, 32); whi_ |= __shfl_xor(whi_, 32);
                    if (g == 0) mrow[(size_t)t * 256] = ((unsigned long long)whi_ << 32) | wlo_;
                }
            } else if (MODE >= 3 && t > u) {
                if (g == 0) mrow[(size_t)t * 256] = 0ull;
            }
        }
        asm volatile("s_waitcnt vmcnt(0)" ::: "memory");
        __syncthreads();
    }
    if (MODE == 4 || MODE == 7) ((LAS unsigned*)(lds + IDX_TAB) + 256)[csub] = ccount;
    if (MODE == 6) asm volatile("s_waitcnt lgkmcnt(0)" ::: "memory");
}

constexpr unsigned IDX_ZOOM = 900u;
template <int FM>
__device__ __forceinline__ void idx_find(LAS unsigned char* lds, int tid, int u, bool exact) {
    const int lane = tid & 63, wid = __builtin_amdgcn_readfirstlane(tid >> 6);
    LAS unsigned* hist = (LAS unsigned*)lds; LAS unsigned* ptab = (LAS unsigned*)(lds + IDX_TAB); LAS unsigned* rtab = ptab + 64; LAS unsigned* atab = ptab + 128; LAS unsigned* ftab = ptab + 192; LAS float* wtab = (LAS float*)(ptab + 768);
    for (int i = 0; i < 8; ++i) {
        const int q = 8 * wid + i;
        unsigned c[8]; unsigned T = 0u;
#pragma unroll
        for (int k = 0; k < 4; ++k) { LAS unsigned* pp = hist + q * 256 + ((4 * lane + k) ^ (FM == 2 ? 0 : (q & 31)));     const unsigned d = *pp; *pp = 0u; c[2 * k] = FM == 2 ? d : (d & 0xffffu); c[2 * k + 1] = FM == 2 ? 0u : (d >> 16); T += c[2 * k] + c[2 * k + 1]; }
        unsigned x = T;
#pragma unroll
        for (int off = 1; off < 64; off <<= 1) { const unsigned y = __shfl_down(x, off); if (lane + off < 64) x += y; }
        const unsigned total = (unsigned)__shfl((int)x, 0);
        const int Wq = 64 * u + q - PADF + 1;
        if (Wq <= 256) { if (FM == 1 && lane == 0) { wtab[q] = -3.0e38f; wtab[64 + q] = -3.0e38f; wtab[128 + q] = 0.f; wtab[192 + q] = 1000.f; } continue; }
        unsigned rank = 256u, rank2 = 256u;
        LAS unsigned* stab = (LAS unsigned*)(lds + MISC_OFF + 2048);
        if (FM == 1 && !exact) { const unsigned rs = (unsigned)((256ull * total + (unsigned)Wq / 2) / (unsigned)Wq); if (lane == 0) stab[q] = rs;
            rank = rs / 2 > 3u ? rs / 2 - 3u : 1u; rank2 = 2u * rs + 8u; if (rank2 > total) rank2 = total; if (rank2 < 1u) rank2 = 1u; }
        if (FM == 3) {
            const unsigned rs = stab[q], ab = atab[q]; const unsigned r1 = rs / 2 > 3u ? rs / 2 - 3u : 1u, r2 = 2u * rs + 8u;
            rank = r1 > ab ? r1 - ab : 0u; rank2 = r2 > ab ? r2 - ab : 1u; if (rank2 > total) rank2 = total; if (rank2 < 1u) rank2 = 1u; }
        if (FM == 2) { if (total < 256u) { if (lane == 0) ftab[1] = 1u; continue; } }
        const unsigned ab0 = x - T;
        unsigned ab = ab0; int sel = -1; unsigned above = 0u, cb = 0u;
#pragma unroll
        for (int k = 7; k >= 0; --k) { if (sel < 0 && ab < rank && rank <= ab + c[k]) { sel = k; above = ab; cb = c[k]; } ab += c[k]; }
        const unsigned long long bal = __ballot(sel >= 0);
        unsigned bstar = 0u, nrank = rank, cbin = 0u;
        if (bal) { const int L = __ffsll((long long)bal) - 1; bstar = 8u * (unsigned)L + (unsigned)__shfl(sel, L); nrank = rank - (unsigned)__shfl((int)above, L); cbin = (unsigned)__shfl((int)cb, L); }
        if (FM == 2) bstar >>= 1;
        if (FM == 2 && (!bal || bstar == (unsigned)IDX_WB - 1u)) { if (lane == 0) ftab[1] = 1u; continue; }
        if (FM == 1 || FM == 3) {
            ab = ab0; int sel2 = -1;
#pragma unroll
            for (int k = 7; k >= 0; --k) { if (sel2 < 0 && ab < rank2 && rank2 <= ab + c[k]) sel2 = k; ab += c[k]; }
            const unsigned long long bal2 = __ballot(sel2 >= 0);
            unsigned bbot = bstar; if (bal2) { const int L2 = __ffsll((long long)bal2) - 1; bbot = 8u * (unsigned)L2 + (unsigned)__shfl(sel2, L2); }
            if (lane == 0) {
                if (FM == 1) { if (bbot > bstar) bbot = bstar;
                    const float lo = qb_lo(bbot), hi = qb_hi(bstar), scale = (float)(IDX_WB - 1) / (hi - lo);
                    wtab[q] = lo; wtab[64 + q] = hi; wtab[128 + q] = scale; wtab[192 + q] = -lo * scale + 1.0f; }
                else {
                    const float lo0 = wtab[q], hi0 = wtab[64 + q], w = 1.0f / wtab[128 + q];
                    unsigned btop = (rank == 0u || !bal) ? 511u : bstar; if (bbot > btop) bbot = btop;
                    float lo = lo0 + (float)bbot * w, hi = (btop >= 511u) ? hi0 : lo0 + (float)(btop + 1u) * w;
                    if (!(hi > lo)) { lo = lo0; hi = hi0; }
                    const float scale = 512.0f / (hi - lo);
                    wtab[q] = lo; wtab[64 + q] = hi; wtab[128 + q] = scale; wtab[192 + q] = -lo * scale + 1.0f; }
            }
        }
        if (FM == 2 && lane == 0) {
            ptab[q] = bstar; rtab[q] = nrank;
            LAS float* ztab = (LAS float*)(lds + MISC_OFF + 1024);
            ztab[128 + q] = 0.f;
            if (cbin > 8u) {
                const float lo = wtab[q], sc = wtab[128 + q], w = 1.0f / sc;
                const float nlo = lo + ((float)bstar - 1.0f) * w, nhi = lo + ((float)bstar + 2.0f) * w;
                if (nhi > nlo) { const float ns = (float)(IDX_WB - 1) / (nhi - nlo);
                    if (cbin > IDX_ZOOM) { wtab[q] = nlo; wtab[64 + q] = nhi; wtab[128 + q] = ns; wtab[192 + q] = -nlo * ns + 1.0f; ftab[2] = 1u; }
                    else { ztab[q] = nlo; ztab[64 + q] = nhi; ztab[128 + q] = ns; ztab[192 + q] = -nlo * ns + 1.0f; } }
            }
        }
    }
}

__device__ __forceinline__ void idx_unit(LAS unsigned char* lds, const bf16_t* QI, const bf16_t* KI, const float* WI, unsigned long long* MASK, const int b, const int u, const int tid) {
    const int lane = tid & 63, wid = __builtin_amdgcn_readfirstlane(tid >> 6), q16 = lane & 15, g = lane >> 4, qg = wid & 3;
    const int a_q = 64 * u + 16 * qg + q16; const size_t row = (size_t)b * RA + a_q;
    const unsigned Wq = a_q >= PADF ? (unsigned)(a_q - PADF + 1) : 0u;
    LAS unsigned* ptab = (LAS unsigned*)(lds + IDX_TAB); LAS unsigned* rtab = ptab + 64;
    for (int i = tid; i < 16384; i += NTHREADS) ((LAS unsigned*)lds)[i] = 0u;
    if (tid < 64) { ptab[tid] = 0u; rtab[tid] = 256u; }
    bf16x8 qf[8][2]; bf16x8 qs[2][2]; float cs[8];
    float qsum[2][8];
#pragma unroll
    for (int ks = 0; ks < 2; ++ks)
#pragma unroll
        for (int j = 0; j < 8; ++j) qsum[ks][j] = 0.f;
#pragma unroll
    for (int h = 0; h < 8; ++h) {
        const float w = WI[row * 8 + h];
        cs[h] = w > 0.f ? 1.f : (w < 0.f ? -1.f : 0.f);
#pragma unroll
        for (int ks = 0; ks < 2; ++ks) {
            const u32x4 raw = *(const u32x4*)(QI + row * 512 + h * 64 + ks * 32 + g * 8);
            u32x4 o; o.x = cvt_pk_bf16(bf_lo(raw.x) * w, bf_hi(raw.x) * w); o.y = cvt_pk_bf16(bf_lo(raw.y) * w, bf_hi(raw.y) * w);
            o.z = cvt_pk_bf16(bf_lo(raw.z) * w, bf_hi(raw.z) * w); o.w = cvt_pk_bf16(bf_lo(raw.w) * w, bf_hi(raw.w) * w);
            qf[h][ks] = *reinterpret_cast<bf16x8*>(&o);
            qsum[ks][0] += bf_lo(o.x); qsum[ks][1] += bf_hi(o.x); qsum[ks][2] += bf_lo(o.y); qsum[ks][3] += bf_hi(o.y);
            qsum[ks][4] += bf_lo(o.z); qsum[ks][5] += bf_hi(o.z); qsum[ks][6] += bf_lo(o.w); qsum[ks][7] += bf_hi(o.w);
        }
    }
#pragma unroll
    for (int ks = 0; ks < 2; ++ks) {
        u32x4 hi, lo;
        { const unsigned hw = cvt_pk_bf16(qsum[ks][0], qsum[ks][1]); hi.x = hw; lo.x = cvt_pk_bf16(qsum[ks][0] - bf_lo(hw), qsum[ks][1] - bf_hi(hw)); }
        { const unsigned hw = cvt_pk_bf16(qsum[ks][2], qsum[ks][3]); hi.y = hw; lo.y = cvt_pk_bf16(qsum[ks][2] - bf_lo(hw), qsum[ks][3] - bf_hi(hw)); }
        { const unsigned hw = cvt_pk_bf16(qsum[ks][4], qsum[ks][5]); hi.z = hw; lo.z = cvt_pk_bf16(qsum[ks][4] - bf_lo(hw), qsum[ks][5] - bf_hi(hw)); }
        { const unsigned hw = cvt_pk_bf16(qsum[ks][6], qsum[ks][7]); hi.w = hw; lo.w = cvt_pk_bf16(qsum[ks][6] - bf_lo(hw), qsum[ks][7] - bf_hi(hw)); }
        qs[0][ks] = *reinterpret_cast<bf16x8*>(&hi); qs[1][ks] = *reinterpret_cast<bf16x8*>(&lo);
    }
    const bf16_t* KIb = KI + (size_t)b * RA * IDIM;
    unsigned long long* mrow = mask_chunk(MASK, b, u >> 2, 0) + (size_t)(64 * (u & 3) + 16 * qg + q16);
    __syncthreads();
    LAS unsigned* ccnt = ptab + 256; LAS unsigned* oflag = ptab + 192; LAS unsigned* wfail = ptab + 193; LAS unsigned* zflag = ptab + 194; LAS unsigned* atab = ptab + 128; LAS float* wtab = (LAS float*)(ptab + 768);
    const int u0 = u; const bf16_t* KIb0 = KIb;
    unsigned long long* gbuf = (unsigned long long*)((unsigned char*)MASK - WS_A0 + WS_AGG) + (size_t)blockIdx.x * (2 * IDX_OVF);
    LAS unsigned* ovfc = ptab + 195;
    int stage = (u0 >= 32) ? 0 : 1, zooms = 0; bool have_window = false;
    const int sstride = (u0 >= 96) ? 8 : 4;
    for (;;) {
        int u = u0; GAS const bf16_t* KIbg_ = (GAS const bf16_t*)KIb0; asm volatile("" : "+s"(u), "+s"(KIbg_)); const bf16_t* KIb = (const bf16_t*)KIbg_;
        if (tid < 64) atab[tid] = 0u; if (tid == 64) { *oflag = 0u; *wfail = 0u; *zflag = 0u; *ovfc = 0u; }
        __syncthreads();
        int pass = have_window ? 2 : 0;
        if (pass == 0) {
            idx_sweep<5>(lds, KIb, qf, qs, cs, u, tid, 0u, a_q, Wq, mrow, stage == 0 ? sstride : 1, 0, 0.f, 0.f, 0.f, 0.f, gbuf);
            idx_find<1>(lds, tid, u, stage != 0); __syncthreads();
            pass = 2;
        }
        float wlo, whi, wsc, wof;
        for (;;) {
            wlo = wtab[16 * qg + q16]; whi = wtab[64 + 16 * qg + q16]; wsc = wtab[128 + 16 * qg + q16]; wof = wtab[192 + 16 * qg + q16];
            idx_sweep<6>(lds, KIb, qf, qs, cs, u, tid, 0u, a_q, Wq, mrow, pass == 1 ? 4 : 1, 0, wlo, whi, wsc, wof, gbuf);
            __syncthreads();
            if (pass == 2) break;
            idx_find<3>(lds, tid, u, false); __syncthreads();
            if (tid < 64) atab[tid] = 0u;
            __syncthreads();
            pass = 2;
        }
        idx_find<2>(lds, tid, u, false); __syncthreads();
        if (*wfail) { if (stage == 0) { stage = 1; have_window = false; __syncthreads(); continue; } }
        else if (*zflag && zooms < 3) { ++zooms; have_window = true; __syncthreads(); continue; }
        idx_sweep<7>(lds, KIb, qf, qs, cs, u, tid, ptab[16 * qg + q16], a_q, Wq, mrow, 1, 0, wlo, whi, wsc, wof, gbuf);
        __syncthreads();
        {
            LAS unsigned long long* clist = (LAS unsigned long long*)lds;
            LAS unsigned long long* tmpw = (LAS unsigned long long*)(lds + IDX_KBUF) + wid * IDX_TMP;
            const unsigned novf = *ovfc < (unsigned)IDX_OVF ? *ovfc : (unsigned)IDX_OVF;
            for (int i = 0; i < 8; ++i) {
                const int q = 8 * wid + i; const unsigned need = rtab[q];
                if (64 * u + q - PADF + 1 <= 256) continue;
                const int sub = q * 8 + (lane >> 3), slot = lane & 7; unsigned c = ccnt[sub]; c = c > (unsigned)IDX_CAP ? (unsigned)IDX_CAP : c;
                const bool v0 = (unsigned)slot < c, v1 = (unsigned)(slot + 8) < c;
                const unsigned long long e0 = v0 ? clist[sub * IDX_CAP + slot] : 0ull, e1 = v1 ? clist[sub * IDX_CAP + slot + 8] : 0ull;
                const unsigned long long bal0 = __ballot(v0), bal1 = __ballot(v1); const int n0 = __popcll(bal0); int n = n0 + __popcll(bal1);
                if (v0) tmpw[(int)__builtin_amdgcn_mbcnt_hi((unsigned)(bal0 >> 32), __builtin_amdgcn_mbcnt_lo((unsigned)bal0, 0u))] = e0;
                if (v1) tmpw[n0 + (int)__builtin_amdgcn_mbcnt_hi((unsigned)(bal1 >> 32), __builtin_amdgcn_mbcnt_lo((unsigned)bal1, 0u))] = e1;
                for (unsigned j0 = 0; j0 < novf; j0 += 64) {
                    const unsigned j = j0 + lane; const bool vq = j < novf && gbuf[2 * j] == (unsigned long long)q;
                    const unsigned long long bq = __ballot(vq);
                    if (vq) { const int idx = n + (int)__builtin_amdgcn_mbcnt_hi((unsigned)(bq >> 32), __builtin_amdgcn_mbcnt_lo((unsigned)bq, 0u)); if (idx < IDX_TMP) tmpw[idx] = gbuf[2 * j + 1]; }
                    n += __popcll(bq);
                }
                if (n > IDX_TMP) n = IDX_TMP;
                if (n == 0) continue;
                asm volatile("s_waitcnt lgkmcnt(0)" ::: "memory");
                for (int c0 = 0; c0 < n; c0 += 64) {
                    const bool va = c0 + lane < n; const unsigned long long ea = va ? tmpw[c0 + lane] : 0ull;
                    const float sa = __uint_as_float((unsigned)(ea >> 32)); const unsigned pa = (unsigned)ea;
                    unsigned ra = 0u;
                    for (int j = 0; j < n; ++j) { const unsigned long long ej = tmpw[j]; const float sj = __uint_as_float((unsigned)(ej >> 32)); const unsigned pj = (unsigned)ej; ra += (sj > sa || (sj == sa && pj < pa)) ? 1u : 0u; }
                    if (va && ra < need) atomicOr(mask_chunk(MASK, b, u >> 2, (int)(pa >> 6)) + (64 * (u & 3) + q), 1ull << (pa & 63u));
                }
                asm volatile("s_waitcnt lgkmcnt(0)" ::: "memory");
            }
        }
        __syncthreads();
        break;
    }
}
__device__ __forceinline__ int queue_pop(unsigned* ctr, volatile LAS unsigned* slot, int tid) {
    if (tid == 0) *slot = __hip_atomic_fetch_add(ctr, 1u, __ATOMIC_RELAXED, __HIP_MEMORY_SCOPE_AGENT);
    __syncthreads();
    const int v = (int)*slot;
    __syncthreads();
    return v;
}
__device__ __forceinline__ void phase_indexer(LAS unsigned char* lds, const bf16_t* QI, const bf16_t* KI, const float* WI, unsigned long long* MASK, unsigned* ctr, const int wid0) {
    constexpr int NITEM = 2 * 257;
    volatile LAS unsigned* slot = (volatile LAS unsigned*)(lds + MISC_OFF) + 16;
    for (;;) {
        const int tid = opaque_tid(wid0);
        const int i = queue_pop(ctr, slot, tid);
        if (i >= NITEM) break;
        idx_unit(lds, QI, KI, WI, MASK, i & 1, 259 - (i >> 1), opaque_tid(wid0));
        __syncthreads();
    }
}


namespace att {
constexpr int NW = 8, QBLK = 32, KVBLK = 64, QB = NW * QBLK, RS = 1024;
constexpr int SHM_V = KVBLK * HD * 2, SHM_K = KVBLK * HD * 2;
constexpr int WS_OFF = 2 * SHM_V + 2 * SHM_K, LUT_OFF = WS_OFF + NW * 64 * 4, EPI_OFF = 69632;
constexpr float SCALE = 0.08838834764831845f;
constexpr float THR = 8.f;
#define KSWZ(row, colB) ((row) * 256 + ((colB) ^ (((row) & 7) << 4)))
#define SBAR() __builtin_amdgcn_sched_barrier(0)
__device__ __forceinline__ int v_st(int k, int c) { const int kk = (k & ~0xC) | ((k & 4) << 1) | ((k & 8) >> 1); return ((kk >> 3) * 4 + (c >> 5)) * 512 + ((kk & 7) * 32 + (c & 31)) * 2; }
__device__ __forceinline__ int v_rd_base(int lane) { return ((lane & 3) << 3) | (((lane >> 2) & 3) << 6) | (((lane >> 4) & 1) << 5) | (((lane >> 5) & 1) << 8); }
constexpr int v_rd_off(int d0, int ks, int half) { return d0 * 512 + ks * 4096 + half * 2048; }
__device__ __forceinline__ int crow(int r, int hi) { return (r & 3) + 8 * (r >> 2) + 4 * hi; }
__device__ __forceinline__ bf16x8 load8(const bf16_t* p) { return *reinterpret_cast<const bf16x8*>(p); }

__device__ __forceinline__ void mask_tile(f32x16& p0, f32x16& p1, unsigned long long mw, int hi) {
    const unsigned long long sh = mw >> (4 * hi);
    const int lo = (int)(unsigned)sh, hh = (int)(unsigned)(sh >> 32);
    const int NEG = (int)0xff800000u;
#pragma unroll
    for (int r = 0; r < 16; ++r) {
        const int c = (r & 3) + 8 * (r >> 2);
        const int m0 = __builtin_amdgcn_sbfe(lo, c, 1), m1 = __builtin_amdgcn_sbfe(hh, c, 1);
        float q0 = p0[r], q1 = p1[r];
        asm("v_bfi_b32 %0, %1, %0, %2" : "+v"(q0) : "v"(m0), "s"(NEG));
        asm("v_bfi_b32 %0, %1, %0, %2" : "+v"(q1) : "v"(m1), "s"(NEG));
        p0[r] = q0; p1[r] = q1;
    }
}
__device__ __forceinline__ void bias_tile(f32x16& p0, f32x16& p1, int dq, const float* lut) {
#pragma unroll
    for (int r = 0; r < 16; ++r) {
        const int c = (r & 3) + 8 * (r >> 2);
        const unsigned d0 = (unsigned)(dq - c), d1 = (unsigned)(dq - c - 32);
        p0[r] += lut[d0 < 127u ? d0 : 127u]; p1[r] += lut[d1 < 127u ? d1 : 127u];
    }
}
__device__ __forceinline__ float max3_s(float a, float b, float c) { float d; asm("v_max3_f32 %0, %1, %2, %3" : "=v"(d) : "v"(a), "v"(b), "v"(c)); return d; }
__device__ __forceinline__ float max2_s(float a, float b) { float d; asm("v_max_f32 %0, %1, %2" : "=v"(d) : "v"(a), "v"(b)); return d; }
__device__ __forceinline__ float max2_s_pl(float a, float b) { float d; asm("v_max_f32 %0, %1, %2\n\ts_nop 1" : "=v"(d) : "v"(a), "v"(b)); return d; }
constexpr float THRL = THR * 1.4426950408889634f;
__device__ __forceinline__ void partialSM(f32x16& p0, f32x16& p1, float& m_ref, f32x16& minit, float& alpha) {
    float pmax = max3_s(p0[0], p0[1], p0[2]);
#pragma unroll
    for (int r = 3; r + 1 < 16; r += 2) pmax = max3_s(pmax, p0[r], p0[r + 1]);
    pmax = max3_s(pmax, p0[15], p1[0]);
#pragma unroll
    for (int r = 1; r + 1 < 16; r += 2) pmax = max3_s(pmax, p1[r], p1[r + 1]);
    pmax = max2_s_pl(pmax, p1[15]);
    { auto rr = __builtin_amdgcn_permlane32_swap(__float_as_uint(pmax), __float_as_uint(pmax), false, false);
      pmax = max2_s(__uint_as_float(rr[0]), __uint_as_float(rr[1])); }
    alpha = 1.f;
    if (!__builtin_expect(__all(pmax <= THRL), 1)) {
        const float d = fmaxf(pmax, 0.f);
        alpha = __builtin_amdgcn_exp2f(-d); m_ref += d;
#pragma unroll
        for (int r = 0; r < 16; ++r) { p0[r] -= d; p1[r] -= d; minit[r] = -m_ref; }
    }
#pragma unroll
    for (int r = 0; r < 16; ++r) p0[r] = __builtin_amdgcn_exp2f(p0[r]);
}
__device__ __forceinline__ void partialSM_post(f32x16& p0, f32x16& p1, float pmax, float& m_ref, f32x16& minit, float& alpha) {
    asm volatile("s_nop 1" ::: );
    { auto rr = __builtin_amdgcn_permlane32_swap(__float_as_uint(pmax), __float_as_uint(pmax), false, false);
      pmax = max2_s(__uint_as_float(rr[0]), __uint_as_float(rr[1])); }
    alpha = 1.f;
    if (!__builtin_expect(__all(pmax <= THRL), 1)) {
        const float d = fmaxf(pmax, 0.f);
        alpha = __builtin_amdgcn_exp2f(-d); m_ref += d;
#pragma unroll
        for (int r = 0; r < 16; ++r) { p0[r] -= d; p1[r] -= d; minit[r] = -m_ref; }
    }
#pragma unroll
    for (int r = 0; r < 16; ++r) p0[r] = __builtin_amdgcn_exp2f(p0[r]);
}
__device__ __forceinline__ void finishSM(f32x16& p0, f32x16& p1, float alpha, float& l_reg, bf16x8& pa0, bf16x8& pa1, bf16x8& pa2, bf16x8& pa3) {
#pragma unroll
    for (int r = 0; r < 16; ++r) p1[r] = __builtin_amdgcn_exp2f(p1[r]);
    float ps = 0;
#pragma unroll
    for (int r = 0; r < 16; ++r) ps += p0[r];
#pragma unroll
    for (int r = 0; r < 16; ++r) ps += p1[r];
    { auto rr = __builtin_amdgcn_permlane32_swap(__float_as_uint(ps), __float_as_uint(ps), false, false);
      ps = __uint_as_float(rr[0]) + __uint_as_float(rr[1]); }
    l_reg = l_reg * alpha + ps;
#define PK4(P, B_, OUT) do { unsigned a0 = cvt_pk_bf16(P[B_+0], P[B_+1]), a1 = cvt_pk_bf16(P[B_+2], P[B_+3]);                          \
        unsigned b0 = cvt_pk_bf16(P[B_+4], P[B_+5]), b1 = cvt_pk_bf16(P[B_+6], P[B_+7]);                                             \
        auto r0 = __builtin_amdgcn_permlane32_swap(a0, b0, false, false); auto r1 = __builtin_amdgcn_permlane32_swap(a1, b1, false, false); \
        u32x4 w = {r0[0], r1[0], r0[1], r1[1]}; OUT = *reinterpret_cast<bf16x8*>(&w); } while (0)
    PK4(p0, 0, pa0); PK4(p0, 8, pa1); PK4(p1, 0, pa2); PK4(p1, 8, pa3);
#undef PK4
}
template <int KB>
__device__ __forceinline__ void qkt(f32x16& p0, f32x16& p1, const char* K_lds, int r32, int hi, const bf16x8* qr, const f32x16& minit) {
    const char* kb[4];
#pragma unroll
    for (int dd = 0; dd < 4; ++dd) kb[dd] = K_lds + KB * SHM_K + KSWZ(r32, (dd * 16 + hi * 8) * 2);
#pragma unroll
    for (int d0 = 0; d0 < 8; ++d0) { const char* a = kb[d0 & 3] + (d0 >> 2) * 128;
        bf16x8 b0 = *reinterpret_cast<const bf16x8*>(a);
        bf16x8 b1 = *reinterpret_cast<const bf16x8*>(a + 32 * 256);
        p0 = __builtin_amdgcn_mfma_f32_32x32x16_bf16(b0, qr[d0], d0 == 0 ? minit : p0, 0, 0, 0);
        p1 = __builtin_amdgcn_mfma_f32_32x32x16_bf16(b1, qr[d0], d0 == 0 ? minit : p1, 0, 0, 0); }
}
template <int KB>
__device__ __forceinline__ void qkt_fsm(f32x16& x0, f32x16& x1, const char* K_lds, int r32, int hi, const bf16x8* qr, const f32x16& minit,
                                        f32x16& y0, f32x16& y1, float alpha, float& l_reg, bf16x8& pa0, bf16x8& pa1, bf16x8& pa2, bf16x8& pa3) {
    const char* kb[4];
#pragma unroll
    for (int dd = 0; dd < 4; ++dd) kb[dd] = K_lds + KB * SHM_K + KSWZ(r32, (dd * 16 + hi * 8) * 2);
    bf16x8 b0 = *reinterpret_cast<const bf16x8*>(kb[0]), b1 = *reinterpret_cast<const bf16x8*>(kb[0] + 32 * 256), n0 = b0, n1 = b1;
    float ps = 0.f; unsigned c[16]; u32x4 w0, w1, w2, w3;
#define FS_GAP(g) do { y1[g] = __builtin_amdgcn_exp2f(y1[g]); ps += y0[g]; if ((g) >= 1) ps += y1[(g) - 1];                                         \
        if ((g) < 8) c[g] = cvt_pk_bf16(y0[2 * (g)], y0[2 * (g) + 1]); else if ((g) < 15) c[g] = cvt_pk_bf16(y1[2 * ((g) - 8)], y1[2 * ((g) - 8) + 1]);   \
        if ((g) == 4)  { auto r_ = __builtin_amdgcn_permlane32_swap(c[0], c[2], false, false); w0[0] = r_[0]; w0[2] = r_[1]; }                                  \
        if ((g) == 5)  { auto r_ = __builtin_amdgcn_permlane32_swap(c[1], c[3], false, false); w0[1] = r_[0]; w0[3] = r_[1]; }                                  \
        if ((g) == 8)  { auto r_ = __builtin_amdgcn_permlane32_swap(c[4], c[6], false, false); w1[0] = r_[0]; w1[2] = r_[1]; }                                  \
        if ((g) == 9)  { auto r_ = __builtin_amdgcn_permlane32_swap(c[5], c[7], false, false); w1[1] = r_[0]; w1[3] = r_[1]; }                                  \
        if ((g) == 12) { auto r_ = __builtin_amdgcn_permlane32_swap(c[8], c[10], false, false); w2[0] = r_[0]; w2[2] = r_[1]; }                                 \
        if ((g) == 13) { auto r_ = __builtin_amdgcn_permlane32_swap(c[9], c[11], false, false); w2[1] = r_[0]; w2[3] = r_[1]; }                                 \
        __builtin_amdgcn_sched_barrier(0); } while (0)
#pragma unroll
    for (int d0 = 0; d0 < 8; ++d0) {
        if (d0 < 7) { const char* a = kb[(d0 + 1) & 3] + ((d0 + 1) >> 2) * 128; n0 = *reinterpret_cast<const bf16x8*>(a); n1 = *reinterpret_cast<const bf16x8*>(a + 32 * 256); }
        x0 = __builtin_amdgcn_mfma_f32_32x32x16_bf16(b0, qr[d0], d0 == 0 ? minit : x0, 0, 0, 0);
        FS_GAP(2 * d0);
        x1 = __builtin_amdgcn_mfma_f32_32x32x16_bf16(b1, qr[d0], d0 == 0 ? minit : x1, 0, 0, 0);
        FS_GAP(2 * d0 + 1);
        b0 = n0; b1 = n1;
    }
#undef FS_GAP
    ps += y1[15]; c[15] = cvt_pk_bf16(y1[14], y1[15]);
    { auto r_ = __builtin_amdgcn_permlane32_swap(c[12], c[14], false, false); w3[0] = r_[0]; w3[2] = r_[1]; }
    { auto r_ = __builtin_amdgcn_permlane32_swap(c[13], c[15], false, false); w3[1] = r_[0]; w3[3] = r_[1]; }
    { auto rr = __builtin_amdgcn_permlane32_swap(__float_as_uint(ps), __float_as_uint(ps), false, false);
      ps = __uint_as_float(rr[0]) + __uint_as_float(rr[1]); }
    l_reg = l_reg * alpha + ps;
    pa0 = *reinterpret_cast<bf16x8*>(&w0); pa1 = *reinterpret_cast<bf16x8*>(&w1); pa2 = *reinterpret_cast<bf16x8*>(&w2); pa3 = *reinterpret_cast<bf16x8*>(&w3);
}
template <int VB>
__device__ __forceinline__ void pv_tile(f32x16* o, int vb0, bf16x8 pa0, bf16x8 pa1, bf16x8 pa2, bf16x8 pa3) {
#define TRRD(dst, off) asm volatile("ds_read_b64_tr_b16 %0, %1 offset:%2" : "=&v"(dst) : "v"(vb0), "i"(off) : "memory")
#define PV_D0(d0) do { s16x4 l0, l1, l2, l3, h0, h1, h2, h3; constexpr int b_ = VB * SHM_V + v_rd_off(d0, 0, 0); \
        TRRD(l0, b_); TRRD(h0, b_ + 2048); TRRD(l1, b_ + 4096); TRRD(h1, b_ + 6144); TRRD(l2, b_ + 8192); TRRD(h2, b_ + 10240); TRRD(l3, b_ + 12288); TRRD(h3, b_ + 14336); \
        asm volatile("s_waitcnt lgkmcnt(0)" ::: "memory"); SBAR();   \
        o[d0] = __builtin_amdgcn_mfma_f32_32x32x16_bf16(pa0, (bf16x8){l0[0], l0[1], l0[2], l0[3], h0[0], h0[1], h0[2], h0[3]}, o[d0], 0, 0, 0);   \
        o[d0] = __builtin_amdgcn_mfma_f32_32x32x16_bf16(pa1, (bf16x8){l1[0], l1[1], l1[2], l1[3], h1[0], h1[1], h1[2], h1[3]}, o[d0], 0, 0, 0);   \
        o[d0] = __builtin_amdgcn_mfma_f32_32x32x16_bf16(pa2, (bf16x8){l2[0], l2[1], l2[2], l2[3], h2[0], h2[1], h2[2], h2[3]}, o[d0], 0, 0, 0);   \
        o[d0] = __builtin_amdgcn_mfma_f32_32x32x16_bf16(pa3, (bf16x8){l3[0], l3[1], l3[2], l3[3], h3[0], h3[1], h3[2], h3[3]}, o[d0], 0, 0, 0); } while (0)
    PV_D0(0); PV_D0(1); PV_D0(2); PV_D0(3);
#undef PV_D0
#undef TRRD
}

template <int VB>
__device__ __forceinline__ float pv_tile_sm(f32x16* o, int vb0, bf16x8 pa0, bf16x8 pa1, bf16x8 pa2, bf16x8 pa3, f32x16& x0, f32x16& x1, unsigned long long mw, int hi) {
    const unsigned long long sh = mw >> (4 * hi);
    const int lo = (int)(unsigned)sh, hh = (int)(unsigned)(sh >> 32);
    const int NEG = (int)0xff800000u;
    float pmax = __int_as_float(NEG);
#define TRRD(dst, off) asm volatile("ds_read_b64_tr_b16 %0, %1 offset:%2" : "=&v"(dst) : "v"(vb0), "i"(off) : "memory")
#define PV_LD(S_, d0) do { constexpr int b_ = VB * SHM_V + v_rd_off(d0, 0, 0); \
        TRRD(S_##l0, b_); TRRD(S_##h0, b_ + 2048); TRRD(S_##l1, b_ + 4096); TRRD(S_##h1, b_ + 6144); TRRD(S_##l2, b_ + 8192); TRRD(S_##h2, b_ + 10240); TRRD(S_##l3, b_ + 12288); TRRD(S_##h3, b_ + 14336); } while (0)
#define PV_WAIT() do { asm volatile("s_waitcnt lgkmcnt(0)" ::: "memory"); SBAR(); } while (0)
#define PV_MMA(S_, d0) do { \
        o[d0] = __builtin_amdgcn_mfma_f32_32x32x16_bf16(pa0, (bf16x8){S_##l0[0], S_##l0[1], S_##l0[2], S_##l0[3], S_##h0[0], S_##h0[1], S_##h0[2], S_##h0[3]}, o[d0], 0, 0, 0);   \
        o[d0] = __builtin_amdgcn_mfma_f32_32x32x16_bf16(pa1, (bf16x8){S_##l1[0], S_##l1[1], S_##l1[2], S_##l1[3], S_##h1[0], S_##h1[1], S_##h1[2], S_##h1[3]}, o[d0], 0, 0, 0);   \
        o[d0] = __builtin_amdgcn_mfma_f32_32x32x16_bf16(pa2, (bf16x8){S_##l2[0], S_##l2[1], S_##l2[2], S_##l2[3], S_##h2[0], S_##h2[1], S_##h2[2], S_##h2[3]}, o[d0], 0, 0, 0);   \
        o[d0] = __builtin_amdgcn_mfma_f32_32x32x16_bf16(pa3, (bf16x8){S_##l3[0], S_##l3[1], S_##l3[2], S_##l3[3], S_##h3[0], S_##h3[1], S_##h3[2], S_##h3[3]}, o[d0], 0, 0, 0); } while (0)
#define SM_SLICE(d0) do { _Pragma("unroll") for (int r = 4 * (d0); r < 4 * (d0) + 4; ++r) { const int c = (r & 3) + 8 * (r >> 2);          \
        const int m0 = __builtin_amdgcn_sbfe(lo, c, 1), m1 = __builtin_amdgcn_sbfe(hh, c, 1); float q0 = x0[r], q1 = x1[r];                        \
        asm("v_bfi_b32 %0, %1, %0, %2" : "+v"(q0) : "v"(m0), "s"(NEG)); asm("v_bfi_b32 %0, %1, %0, %2" : "+v"(q1) : "v"(m1), "s"(NEG));             \
        x0[r] = q0; x1[r] = q1; pmax = max3_s(pmax, q0, q1); } } while (0)
    s16x4 Al0, Al1, Al2, Al3, Ah0, Ah1, Ah2, Ah3, Bl0, Bl1, Bl2, Bl3, Bh0, Bh1, Bh2, Bh3;
    PV_LD(A, 0); PV_WAIT();
    PV_MMA(A, 0); PV_LD(B, 1); SM_SLICE(0); PV_WAIT();
    PV_MMA(B, 1); PV_LD(A, 2); SM_SLICE(1); PV_WAIT();
    PV_MMA(A, 2); PV_LD(B, 3); SM_SLICE(2); PV_WAIT();
    PV_MMA(B, 3); SM_SLICE(3);
#undef SM_SLICE
#undef PV_MMA
#undef PV_WAIT
#undef PV_LD
#undef TRRD
    return pmax;
}

struct Blk { const bf16_t* Q; const bf16_t* K; const bf16_t* V; const bf16_t* Gt; bf16_t* Y; const unsigned long long* M; int P0; int NT; };
struct Seam { bf16x8 qr[8]; bf16x8 st_v0, st_v1, st_k0, st_k1; };
#define ROW(p, k0, rr) ((p) + (size_t)((k0) + (rr)) * RS + sc)
#define VMW() asm volatile("s_waitcnt vmcnt(0)" ::: "memory")
#define VMWN(n) asm volatile("s_waitcnt vmcnt(%0)" :: "i"(n) : "memory")
#define SLOAD_H(Kp, Vp, k0) do { const char* kt_ = (const char*)(Kp) + (size_t)(k0) * (RS * 2); const char* vt_ = (const char*)(Vp) + (size_t)(k0) * (RS * 2);   \
                         S.st_v0 = *(const bf16x8*)(vt_ + ldo0); S.st_v1 = *(const bf16x8*)(vt_ + 32 * RS * 2 + ldo0);              \
                         S.st_k0 = *(const bf16x8*)(kt_ + ldo0); S.st_k1 = *(const bf16x8*)(kt_ + 32 * RS * 2 + ldo0); } while (0)
#define SWRITE_HK(bf) do { *(bf16x8*)(K_lds + (bf) * SHM_K + kws) = S.st_k0; *(bf16x8*)(K_lds + (bf) * SHM_K + kws + 32 * 256) = S.st_k1; } while (0)
#define SWRITE_HV(bf) do { *(bf16x8*)(V_lds + (bf) * SHM_V + vst0) = S.st_v0; *(bf16x8*)(V_lds + (bf) * SHM_V + vst0 + 8192) = S.st_v1; } while (0)
#define SWRITE_H(bf) do { SWRITE_HV(bf); SWRITE_HK(bf); } while (0)
__device__ __forceinline__ void prime(const Blk& cur, char* lds, Seam& S, int tid) {
    const int wid = __builtin_amdgcn_readfirstlane(tid >> 6), lane = tid & 63, r32 = lane & 31, hi = lane >> 5;
    const int sr = tid >> 4, sc = (tid & 15) * 8, kws = KSWZ(sr, sc * 2); char* K_lds = lds + 2 * SHM_V;
    const unsigned ldo0 = (unsigned)(sr * RS + sc) * 2u;
    const int kb0 = 3 * KVBLK;
#pragma unroll
    for (int d0 = 0; d0 < 8; ++d0) S.qr[d0] = load8(cur.Q + (size_t)(cur.P0 + wid * QBLK + r32) * RS + d0 * 16 + hi * 8);
    SLOAD_H(cur.K, cur.V, kb0); VMW(); SWRITE_HK(0);
    __syncthreads();
}
__device__ __forceinline__ void block(const Blk& cur, const Blk& nxt, const float* lutg, char* lds, Seam& S, int tid, const bool dry) {
    const int wid = __builtin_amdgcn_readfirstlane(tid >> 6), lane = tid & 63, r32 = lane & 31, hi = lane >> 5;
    const int NT = cur.NT;
    const int kbn = 3 * KVBLK;
    const int qlo = cur.P0 + wid * QBLK, qm = qlo + r32 - 4 * hi;
    char* V_lds = lds; char* K_lds = lds + 2 * SHM_V;
    float* ws = (float*)(lds + WS_OFF) + wid * 64; float* li_l = ws, * al_l = ws + 32;
    float* lut = (float*)(lds + LUT_OFF);
    { int tl = tid; asm volatile("" : "+v"(tl)); if (tl < 128) lut[tl] = lutg[tl]; }
    float m_reg = 0.f, l_reg = 0; f32x16 o[4] = {}; f32x16 minit = {};
    const int sr = tid >> 4, sc = (tid & 15) * 8, vst0 = v_st(sr, sc), kws = KSWZ(sr, sc * 2);
    const unsigned ldo0 = (unsigned)(sr * RS + sc) * 2u;
    const int vb0 = (int)(uintptr_t)V_lds + v_rd_base(lane);
    const bf16_t* Kh = cur.K; const bf16_t* Vh = cur.V;
    const unsigned moff = (unsigned)(wid * QBLK + r32) * 8u;
#define RESC(a) do { if (__any((a) < 1.f)) { if (hi == 0) al_l[r32] = (a); asm volatile("s_waitcnt lgkmcnt(0)" ::: "memory");              \
                     for (int d_ = 0; d_ < 4; ++d_) for (int r = 0; r < 16; ++r) o[d_][r] *= al_l[crow(r, hi)]; } } while (0)
#define KBASE(t) ((3 + (t)) * KVBLK)
#define MLOAD(t) (*(const unsigned long long*)((const char*)cur.M + (size_t)(3 + (t)) * 2048 + moff))
#define MASKT(P0_, P1_, mw_, t) do { const int kb_ = KBASE(t); if (kb_ + KVBLK - 1 + 113 > qlo) bias_tile(P0_, P1_, qm - kb_, lut); mask_tile(P0_, P1_, mw_, hi); } while (0)
    constexpr int NQL = 8;
#define SEAM_K0() do { VMWN(NQL); SWRITE_HK(0); SBAR(); } while (0)
    f32x16 pA0, pA1, pB0, pB1; float alA, alB; bf16x8 pa0, pa1, pa2, pa3; unsigned long long mwA, mwB;
    SWRITE_HV(0); SBAR();
    mwA = MLOAD(0);
    if (NT > 1) SLOAD_H(Kh, Vh, KBASE(1));
    SBAR(); qkt<0>(pA0, pA1, K_lds, r32, hi, S.qr, minit);
    __syncthreads();
    asm volatile("s_nop 15\n\ts_nop 3" ::: "memory");
    MASKT(pA0, pA1, mwA, 0); partialSM(pA0, pA1, m_reg, minit, alA);
    if (NT > 1) { VMW(); SWRITE_HK(1); }
    __syncthreads();
#define HALF_STEP(PX0, PX1, mnX, alX, mwX, PY0, PY1, alY, t, KB, VB, SB) do {                                                      \
        SWRITE_HV(KB); SBAR(); mwX = MLOAD(t); if ((t) + 1 < NT) { SLOAD_H(Kh, Vh, KBASE((t) + 1)); SBAR(); }       \
        qkt_fsm<KB>(PX0, PX1, K_lds, r32, hi, S.qr, minit, PY0, PY1, alY, l_reg, pa0, pa1, pa2, pa3); SBAR();      \
        { const int kb_ = KBASE(t); if (kb_ + KVBLK - 1 + 113 > qlo) { int lt_ = r32 | (hi << 5); asm volatile("" : "+v"(lt_)); bias_tile(PX0, PX1, qlo + (lt_ & 31) - 4 * (lt_ >> 5) - kb_, lut); } }   \
        { const float pm_ = pv_tile_sm<VB>(o, vb0, pa0, pa1, pa2, pa3, PX0, PX1, mwX, hi);                                                                          \
          if ((t) + 1 < NT) { VMW(); SWRITE_HK(SB); }                   \
          partialSM_post(PX0, PX1, pm_, m_reg, minit, alX); }                                                                                                              \
        RESC(alX); __syncthreads(); } while (0)
    for (int t = 1; t + 1 < NT; t += 2) {
        HALF_STEP(pB0, pB1, mnB, alB, mwB, pA0, pA1, alA, t, 1, 0, 0);
        HALF_STEP(pA0, pA1, mnA, alA, mwA, pB0, pB1, alB, t + 1, 0, 1, 1);
    }
    const bool even = (NT & 1) == 0;
    if (even) { SWRITE_HV(1); SBAR(); mwB = MLOAD(NT - 1); qkt<1>(pB0, pB1, K_lds, r32, hi, S.qr, minit); SBAR(); }
    SLOAD_H(nxt.K, nxt.V, kbn); SBAR();
    unsigned qlo_; { int lt = r32 | (hi << 5); asm volatile("" : "+v"(lt)); qlo_ = (unsigned)((lt & 31) * RS + (lt >> 5) * 8) * 2u; }
#pragma unroll
    for (int d0 = 0; d0 < 8; ++d0) S.qr[d0] = *(const bf16x8*)((const char*)(nxt.Q + (size_t)(nxt.P0 + wid * QBLK) * RS) + qlo_ + d0 * 32);
    SBAR();
    finishSM(pA0, pA1, alA, l_reg, pa0, pa1, pa2, pa3); SBAR();
    pv_tile<0>(o, vb0, pa0, pa1, pa2, pa3);
    if (even) { MASKT(pB0, pB1, mwB, NT - 1); partialSM(pB0, pB1, m_reg, minit, alB); __syncthreads(); RESC(alB);
        finishSM(pB0, pB1, alB, l_reg, pa0, pa1, pa2, pa3); SBAR(); pv_tile<1>(o, vb0, pa0, pa1, pa2, pa3); }
    SBAR(); SEAM_K0();
    if (hi == 0) li_l[r32] = l_reg; asm volatile("s_waitcnt lgkmcnt(0)" ::: "memory");
    { int ln = r32 | (hi << 5); asm volatile("" : "+v"(ln));
      char* et = lds + EPI_OFF + (qlo & 255) * 256;
      char* eb = et + (ln >> 5) * 1024 + (ln & 31) * 2; const float* lb = li_l + (ln >> 5) * 4;
      u32x4 gw[4], yw[4], gx[4], yx[4];
#pragma unroll
      for (int i4 = 0; i4 < 4; ++i4) { const int idx = i4 * 64 + ln; const size_t off = (size_t)(qlo + (idx >> 4)) * RS + (idx & 15) * 8;
          gw[i4] = *(const u32x4*)(cur.Gt + off); yw[i4] = *(const u32x4*)(cur.Y + off); }
#pragma unroll
      for (int i4 = 0; i4 < 4; ++i4) { const int idx = (4 + i4) * 64 + ln; const size_t off = (size_t)(qlo + (idx >> 4)) * RS + (idx & 15) * 8;
          gx[i4] = *(const u32x4*)(cur.Gt + off); yx[i4] = *(const u32x4*)(cur.Y + off); }
#pragma unroll
      for (int r = 0; r < 16; ++r) { const int cr = (r & 3) + 8 * (r >> 2); const float rli = __builtin_amdgcn_rcpf(lb[cr]);
#pragma unroll
          for (int d0 = 0; d0 < 4; ++d0) *(unsigned short*)(eb + cr * 256 + d0 * 64) = (unsigned short)cvt_pk_bf16(o[d0][r] * rli, 0.f); }
      asm volatile("s_waitcnt lgkmcnt(0)" ::: "memory");
#pragma unroll
      for (int i8 = 0; i8 < 8; ++i8) { const int idx = i8 * 64 + ln, row = idx >> 4, ch = idx & 15; const int a = qlo + row;
          const u32x4 ov = *(const u32x4*)(et + row * 256 + ch * 16); const u32x4 g_ = i8 < 4 ? gw[i8 & 3] : gx[i8 & 3], y_ = i8 < 4 ? yw[i8 & 3] : yx[i8 & 3]; u32x4 res;
#pragma unroll
          for (int j = 0; j < 4; ++j) res[j] = cvt_pk_bf16(bf_lo(y_[j]) + sigm_fast(bf_lo(g_[j])) * bf_lo(ov[j]), bf_hi(y_[j]) + sigm_fast(bf_hi(g_[j])) * bf_hi(ov[j]));
          if (a >= PADF && !dry) *(u32x4*)(cur.Y + (size_t)a * RS + ch * 8) = res; } }
    __syncthreads();
#undef RESC
#undef KBASE
#undef MLOAD
#undef MASKT
#undef SEAM_K0
#undef HALF_STEP
}
#undef ROW
#undef VMW
#undef VMWN
#undef SLOAD_H
#undef SWRITE_HK
#undef SWRITE_HV
#undef SWRITE_H
#undef KSWZ
#undef SBAR
}
__device__ __forceinline__ att::Blk attn_blk(int i, const bf16_t* Q, const bf16_t* K, const bf16_t* V, const bf16_t* Gt, bf16_t* Y, const unsigned long long* MASK) {
    const int qblk = 64 - (i >> 4), bh = i & 15, b = bh >> 3, h = bh & 7; const size_t base = (size_t)b * RA * D + h * HD;
    att::Blk r; r.Q = Q + base; r.K = K + base; r.V = V + base; r.Gt = Gt + base; r.Y = Y + base; r.M = mask_chunk(const_cast<unsigned long long*>(MASK), b, qblk, 0); r.P0 = 256 * qblk; r.NT = 4 * qblk + 1;
    return r;
}
__device__ __forceinline__ void phase_attention(LAS unsigned char* lds_, const bf16_t* Q, const bf16_t* K, const bf16_t* V, const bf16_t* Gt, bf16_t* Y, const unsigned long long* MASK, const float* LUT, unsigned* ctr, const bool dry, const int wid0) {
    const int tid = opaque_tid(wid0);
    char* lds = (char*)lds_;
    constexpr int NITEM = 16 * 65;
    volatile LAS unsigned* slot = (volatile LAS unsigned*)(lds_ + MISC_OFF) + 17;
    int i = queue_pop(ctr, slot, tid);
    if (i >= NITEM) return;
    att::Blk cur = attn_blk(i, Q, K, V, Gt, Y, MASK);
    att::Seam S;
    if (__builtin_amdgcn_readfirstlane(tid) >= 256) __builtin_amdgcn_s_setprio(1);
    att::prime(cur, lds, S, tid);
    for (;;) {
        const int in = queue_pop(ctr, slot, tid);
        const bool last = in >= NITEM;
        const att::Blk nxt = last ? cur : attn_blk(in, Q, K, V, Gt, Y, MASK);
        att::block(cur, nxt, LUT + (i & 7) * 128, lds, S, tid, dry);
        if (last) break;
        cur = nxt; i = in;
    }
    __builtin_amdgcn_s_setprio(0);
}

#ifndef N_LAUNCH_MODE
#define N_LAUNCH_MODE 1
#endif
constexpr int NPH_LAYER = 14;
constexpr int PH_FINAL = 1 + DEPTH * NPH_LAYER;
#ifndef ENABLE_ATTN
#define ENABLE_ATTN 1
#endif

#ifndef PMASK
#define PMASK 0xFFFFFFFFu
#endif
#define RUN(p) ((((PMASK) >> ((p) == 0 ? 30 : (p) == PH_FINAL ? 31 : ((p) - 1) % NPH_LAYER)) & 1u) && lo <= (p) && (p) < hi)
#ifndef PROBE_BARX
#define PROBE_BARX 0
#endif
#define GRIDBAR() do { GAS unsigned char* wsbg_ = (GAS unsigned char*)A.ws; asm volatile("" : "+s"(wsbg_)); unsigned char* wsb_ = (unsigned char*)wsbg_; XcdBarrier b_; b_.bar = (unsigned*)(wsb_ + WS_CTL) + 4096; b_.x = xb_xcc_id(); b_.st = (volatile LAS unsigned*)(lds + MISC_OFF) + 8; xcd_barrier(b_, opaque_tid(wid0)); } while (0)
#define SEAM(p) do { if (RUN((p) + 1)) { GRIDBAR(); for (int _b = 0; _b < PROBE_BARX; ++_b) GRIDBAR(); } } while (0)
#ifndef PROBE_DUP
#define PROBE_DUP 0u
#endif
#ifndef PROBE_DUPBAR
#define PROBE_DUPBAR 0
#endif
#define DUPRUN(k, ...) do { if constexpr (((PROBE_DUP) >> (k)) & 1u) { __VA_ARGS__ if (PROBE_DUPBAR) GRIDBAR(); } } while (0)
#define PHASE_BEGIN() GAS unsigned char* wsg_ = (GAS unsigned char*)A.ws; asm volatile("" : "+s"(wsg_)); unsigned char* ws = (unsigned char*)wsg_; const int G = gridDim.x; \
    bf16_t* SA0 = (bf16_t*)(ws + WS_A0); bf16_t* SA1 = (bf16_t*)(ws + WS_A1); bf16_t* SB0 = (bf16_t*)(ws + WS_B0); bf16_t* SB1 = (bf16_t*)(ws + WS_B1); bf16_t* SB2 = (bf16_t*)(ws + WS_B2); bf16_t* SB3 = (bf16_t*)(ws + WS_B3); \
    bf16_t* QI = (bf16_t*)(ws + WS_QI); bf16_t* KI = (bf16_t*)(ws + WS_KI); float* WI = (float*)(ws + WS_WI); float* AGG = (float*)(ws + WS_AGG); float* CARRY = (float*)(ws + WS_CARRY); float* hmeta = (float*)(ws + WS_HMETA); \
    (void)G; (void)SA0; (void)SA1; (void)SB0; (void)SB1; (void)SB2; (void)SB3; (void)QI; (void)KI; (void)WI; (void)AGG; (void)CARRY; (void)hmeta;

template <int l>
__device__ __forceinline__ void layer_phases(const Args& A, LAS unsigned char* lds, const int lo, const int hi, const int wid0) {
        constexpr int pb = 1 + l * NPH_LAYER;
        if (RUN(pb + 0)) { PHASE_BEGIN(); DUPRUN(0, { if (l == 0) phase_rmsnorm<0>(A, A.norm1_g, SA0, wid0); else phase_rmsnorm<1>(A, A.norm1_g + l * D, SA0, wid0); }); if (l == 0) phase_rmsnorm<0>(A, A.norm1_g, SA0, wid0, SB1, SB2); else phase_rmsnorm<1>(A, A.norm1_g + l * D, SA0, wid0, SB1, SB2); SEAM(pb + 0); }
        if (RUN(pb + 1)) { PHASE_BEGIN(); const bf16_t* Win = (const bf16_t*)(ws + WS_WIN + (size_t)l * 16 * MiB);
            pg8::Gemm g{SA0, Win, D, D, D}; pg8::StaticOrder S; S.init(NB * SEQ, NA, G, (int)blockIdx.x);
            pg8::EpiProj E{SB0, SB1, SB2, SB2, QI, KI, WI}; DUPRUN(1, { pg8::gemm_phase(lds, g, S, E, wid0); }); pg8::gemm_phase(lds, g, S, E, wid0);
            { MEpiProj ME{SB0, SB1, SB2, SB2, QI, KI, WI}; meta_gemm(lds, SA0, D, Win, D, NA, D, 1, 1, ME, wid0); } SEAM(pb + 1); }
        if (RUN(pb + 2)) { PHASE_BEGIN(); DUPRUN(2, { phase_conv(SB1, SB3, A.conv_w + l * 4 * D, A.conv_b + l * D, G, wid0); }); phase_conv(SB1, SB3, A.conv_w + l * 4 * D, A.conv_b + l * D, G, wid0); SEAM(pb + 2); }
        if (RUN(pb + 3)) { PHASE_BEGIN(); const bf16_t* Wrg = (const bf16_t*)(ws + WS_WRG + (size_t)l * MiB);
            pg8::Gemm g{SB3, Wrg, D, 256, 256}; pg8::GroupOrder S; S.init(NB * SEQ, 2048, G, (int)blockIdx.x);
            pg8::EpiRGPre E{SA1, SB1}; DUPRUN(3, { pg8::gemm_phase(lds, g, S, E, wid0); }); pg8::gemm_phase(lds, g, S, E, wid0);
            { MEpiRG ME{SA1, SB1}; meta_gemm(lds, SB3, D, Wrg, 256, 2048, 256, 1, 4, ME, wid0); } SEAM(pb + 3); }
        if (RUN(pb + 4)) { PHASE_BEGIN(); DUPRUN(4, { phase_scan_local(SA1, SB1, SB3, A.b_rg_a + l * D, A.b_rg_x + l * D, A.lru_lambda + l * D, AGG, G, A.ph_hi > 0, wid0); }); phase_scan_local(SA1, SB1, SB3, A.b_rg_a + l * D, A.b_rg_x + l * D, A.lru_lambda + l * D, AGG, G, false, wid0); SEAM(pb + 4); }
        if (RUN(pb + 5)) { PHASE_BEGIN(); DUPRUN(5, { phase_scan_carry(AGG, CARRY, wid0); }); phase_scan_carry(AGG, CARRY, wid0); SEAM(pb + 5); }
        if (RUN(pb + 6)) { PHASE_BEGIN(); DUPRUN(6, { phase_scan_apply((const _Float16*)SA1, (const _Float16*)SB1, CARRY, SB0, SB2, SB3, G, wid0); }); phase_scan_apply((const _Float16*)SA1, (const _Float16*)SB1, CARRY, SB0, SB2, SB3, G, wid0); SEAM(pb + 6); }
        if (RUN(pb + 7)) {
#if ENABLE_ATTN
            PHASE_BEGIN(); const bf16_t* Win = (const bf16_t*)(ws + WS_WIN + (size_t)l * 16 * MiB);
            pg8::Gemm g{SA0, Win + (size_t)NA * D, D, D, D}; pg8::StaticOrder S; S.init(NB * SEQ, NBP, G, (int)blockIdx.x);
            pg8::EpiProj E{SB0, SB1, SB2, SA1, QI, KI, WI}; DUPRUN(7, { pg8::gemm_phase(lds, g, S, E, wid0); }); pg8::gemm_phase(lds, g, S, E, wid0);
            { MEpiProj ME{SB0, SB1, SB2, SA1, QI, KI, WI}; meta_gemm(lds, SA0, D, Win + (size_t)NA * D, D, NBP, D, 1, 1, ME, wid0); }
#endif
            SEAM(pb + 7); }
        if (RUN(pb + 8)) {
#if ENABLE_ATTN
            PHASE_BEGIN(); unsigned* qc = (unsigned*)(ws + WS_CTL) + 8192 + (l * 4) * 64; DUPRUN(8, { phase_indexer(lds, QI, KI, WI, (unsigned long long*)SA0, qc + 64, wid0); __syncthreads(); }); phase_indexer(lds, QI, KI, WI, (unsigned long long*)SA0, qc, wid0);
#endif
            SEAM(pb + 8); }
        if (RUN(pb + 9)) {
#if ENABLE_ATTN
            PHASE_BEGIN(); unsigned* qc = (unsigned*)(ws + WS_CTL) + 8192 + (l * 4 + 2) * 64; DUPRUN(9, { phase_attention(lds, SB0, SB1, SB2, SA1, SB3, (const unsigned long long*)SA0, (const float*)(ws + WS_LUT), qc + 64, A.ph_hi > 0, wid0); __syncthreads(); }); phase_attention(lds, SB0, SB1, SB2, SA1, SB3, (const unsigned long long*)SA0, (const float*)(ws + WS_LUT), qc, false, wid0);
#endif
            SEAM(pb + 9); }
        if (RUN(pb + 10)) { PHASE_BEGIN(); const bf16_t* Wout = (const bf16_t*)(ws + WS_WOUT + (size_t)l * 2 * MiB);
            pg8::Gemm g{SB3, Wout, D, D, D}; pg8::StaticOrder S; S.init(NB * SEQ, D, G, (int)blockIdx.x);
            pg8::EpiRes E{A.out, hmeta, 0, l == 0 ? (long)(A.x - A.out) : 0l}; DUPRUN(10, { pg8::EpiRes Ed{A.out, hmeta, A.ph_hi > 0, 0l}; pg8::gemm_phase(lds, g, S, Ed, wid0); }); pg8::gemm_phase(lds, g, S, E, wid0);
            if (l + 1 < DEPTH) { MEpiRes ME{A.out, hmeta}; meta_gemm(lds, SB3, D, Wout, D, D, D, 4, 1, ME, wid0); } SEAM(pb + 10); }
        if (RUN(pb + 11)) { PHASE_BEGIN(); DUPRUN(11, { phase_rmsnorm<1>(A, A.norm2_g + l * D, SA0, wid0); }); phase_rmsnorm<1>(A, A.norm2_g + l * D, SA0, wid0); SEAM(pb + 11); }
        if (RUN(pb + 12)) { PHASE_BEGIN(); const bf16_t* W1 = (const bf16_t*)(ws + WS_W1 + (size_t)l * 8 * MiB);
            pg8::Gemm g{SA0, W1, D, D, D}; pg8::StaticOrder S; S.init(NB * SEQ, FF, G, (int)blockIdx.x);
            pg8::EpiRelu2 E{SB0, FF}; DUPRUN(12, { pg8::gemm_phase(lds, g, S, E, wid0); }); pg8::gemm_phase(lds, g, S, E, wid0);
            if (l + 1 < DEPTH) { MEpiRelu2 ME{SB0}; meta_gemm(lds, SA0, D, W1, D, FF, D, 1, 1, ME, wid0); } SEAM(pb + 12); }
        if (RUN(pb + 13)) { PHASE_BEGIN(); const bf16_t* W2 = (const bf16_t*)(ws + WS_W2 + (size_t)l * 8 * MiB);
            pg8::Gemm g{SB0, W2, FF, FF, FF}; pg8::StaticOrder S; S.init(NB * SEQ, D, G, (int)blockIdx.x);
            pg8::EpiRes E{A.out, hmeta, 0, 0l}; DUPRUN(13, { pg8::EpiRes Ed{A.out, hmeta, A.ph_hi > 0, 0l}; pg8::gemm_phase(lds, g, S, Ed, wid0); }); pg8::gemm_phase(lds, g, S, E, wid0);
            if (l + 1 < DEPTH) { MEpiRes ME{A.out, hmeta}; meta_gemm(lds, SB0, FF, W2, FF, D, FF, 4, 1, ME, wid0); } SEAM(pb + 13); }
}

__global__ void __launch_bounds__(NTHREADS, 2) mega_fwd(Args A_) {
    Args A = A_;
    A.x = as_global(A.x); A.norm1_g = as_global(A.norm1_g); A.w_in = as_global(A.w_in); A.conv_w = as_global(A.conv_w); A.conv_b = as_global(A.conv_b); A.w_rg_a = as_global(A.w_rg_a); A.b_rg_a = as_global(A.b_rg_a);
    A.w_rg_x = as_global(A.w_rg_x); A.b_rg_x = as_global(A.b_rg_x); A.lru_lambda = as_global(A.lru_lambda); A.w_out = as_global(A.w_out); A.norm2_g = as_global(A.norm2_g); A.w_mlp1 = as_global(A.w_mlp1); A.w_mlp2 = as_global(A.w_mlp2);
    A.rel_bias = as_global(A.rel_bias); A.meta = as_global(A.meta); A.final_g = as_global(A.final_g); A.out = as_global(A.out); A.ws = as_global(A.ws);
    extern __shared__ __attribute__((aligned(16))) unsigned char lds_raw[];
    LAS unsigned char* lds = (LAS unsigned char*)lds_raw;
    volatile LAS unsigned* MISC = (volatile LAS unsigned*)(lds + MISC_OFF);
    const int wid0 = __builtin_amdgcn_readfirstlane(threadIdx.x >> 6);
    if (threadIdx.x < 64) MISC[threadIdx.x] = 0u;
    __syncthreads();
    (void)xcd_barrier_post((unsigned*)(A.ws + WS_CTL) + 4096, MISC + 8);
    const int lo = A.ph_lo, hi = A.ph_hi;
    if (RUN(0)) { DUPRUN(14, { phase_prologue(A, lds, wid0); __syncthreads(); }); phase_prologue(A, lds, wid0); __syncthreads(); if (N_LAUNCH_MODE == 0) SEAM(0); }
    layer_phases<0>(A, lds, lo, hi, wid0);
    layer_phases<1>(A, lds, lo, hi, wid0);
    if (RUN(PH_FINAL)) phase_rmsnorm<2>(A, A.final_g, nullptr, wid0);
}
#undef RUN
#undef SEAM

extern "C" void kernel_launch(void* const* d_in, const int* in_sizes, int n_in, void* d_out, int out_size, void* d_ws, size_t ws_size, hipStream_t stream) {
    static int grid = 0;
    if (grid == 0) {
        if (n_in != 17 || out_size != NB * SEQ * D || ws_size < WS_END) { fprintf(stderr, "kernel_launch: unexpected shapes (n_in %d out %d ws %zu)\n", n_in, out_size, ws_size); grid = -1; return; }
        int dev = 0, cus = 0, per_cu = 0;
        if (hipGetDevice(&dev) != hipSuccess || hipDeviceGetAttribute(&cus, hipDeviceAttributeMultiprocessorCount, dev) != hipSuccess) { grid = -1; return; }
        if (hipFuncSetAttribute((const void*)mega_fwd, hipFuncAttributeMaxDynamicSharedMemorySize, LDS_BYTES) != hipSuccess) { fprintf(stderr, "kernel_launch: hipFuncSetAttribute failed\n"); grid = -1; return; }
        if (hipOccupancyMaxActiveBlocksPerMultiprocessor(&per_cu, (const void*)mega_fwd, NTHREADS, LDS_BYTES) != hipSuccess || per_cu < 1) { fprintf(stderr, "kernel_launch: occupancy query says %d\n", per_cu); }
        (void)hipGetLastError();
        grid = cus;
    }
    if (grid < 0) return;
    (void)hipMemsetAsync((char*)d_ws + WS_CTL, 0, CTL_ZERO_BYTES, stream);
    Args a{};
    a.x = (const float*)d_in[0]; a.norm1_g = (const float*)d_in[1]; a.w_in = (const float*)d_in[2]; a.conv_w = (const float*)d_in[3]; a.conv_b = (const float*)d_in[4];
    a.w_rg_a = (const float*)d_in[5]; a.b_rg_a = (const float*)d_in[6]; a.w_rg_x = (const float*)d_in[7]; a.b_rg_x = (const float*)d_in[8]; a.lru_lambda = (const float*)d_in[9];
    a.w_out = (const float*)d_in[10]; a.norm2_g = (const float*)d_in[11]; a.w_mlp1 = (const float*)d_in[12]; a.w_mlp2 = (const float*)d_in[13]; a.rel_bias = (const float*)d_in[14];
    a.meta = (const float*)d_in[15]; a.final_g = (const float*)d_in[16]; a.out = (float*)d_out; a.ws = (unsigned char*)d_ws;
#if N_LAUNCH_MODE == 1
    a.ph_lo = 0; a.ph_hi = PH_FINAL + 1;
    hipLaunchKernelGGL(mega_fwd, dim3(grid), dim3(NTHREADS), LDS_BYTES, stream, a);
#else
    for (int p = 0; p <= PH_FINAL; ++p) { a.ph_lo = p; a.ph_hi = p + 1; hipLaunchKernelGGL(mega_fwd, dim3(grid), dim3(NTHREADS), LDS_BYTES, stream, a); }
#endif
}
```
